# Optimizing an MI355X kernel written in HIP

```python
import jax, jax.numpy as jnp
from jax import lax
import numpy as np

D_MODEL = 1024
BATCH = 8
SEQ = 2048
DEPTH = 2
DEC_BATCH = 8
DEC_SEQ = 32
PAST_LEN = 1024

CHUNK = 64
MIX_WIDTH = D_MODEL
SGU_WIDTH = MIX_WIDTH // 2
SGU_GROUPS = 4
SGU_GROUP_DIM = SGU_WIDTH // SGU_GROUPS
SGU_CHUNK = 128
DN_WIDTH = MIX_WIDTH - SGU_WIDTH
DN_HEADS = 4
DN_HEAD_DIM = DN_WIDTH // DN_HEADS
CONV_W = 4
CONV_CH = 3 * DN_WIDTH
D_FF = 4 * D_MODEL
IN_WIDTH = 2 * SGU_WIDTH + CONV_CH + DN_WIDTH + 2 * DN_HEADS
EPS = 1e-6

kernel_name = "hybrid_sgu_gdn_stream_step"


def rmsnorm(x, g):
    xf = x.astype(jnp.float32)
    y = xf * lax.rsqrt(jnp.mean(xf * xf, axis=-1, keepdims=True) + EPS)
    return (y * g.astype(jnp.float32)).astype(x.dtype)


def l2norm(x):
    xf = x.astype(jnp.float32)
    return xf * lax.rsqrt(jnp.sum(xf * xf, axis=-1, keepdims=True) + EPS)


def spatial_gating(u, v, w_s, b_s):
    B, L, _ = u.shape
    P = SGU_CHUNK if L % SGU_CHUNK == 0 else L
    n = L // P
    blk = jnp.arange(P) // CHUNK
    mask = blk[None, :] <= blk[:, None]
    w = jnp.where(mask[None], w_s[:, :P, :P], 0).astype(v.dtype)
    vb = v.reshape(B, n, P, SGU_GROUPS, SGU_GROUP_DIM)
    bias = jnp.swapaxes(b_s[:, :P], 0, 1)[None, None, :, :, None]
    s = jnp.einsum('gpq,bnqgc->bnpgc', w, vb) + bias.astype(v.dtype)
    return u * s.reshape(B, L, SGU_WIDTH)


def causal_conv(x, buf, w):
    L = x.shape[1]
    xp = jnp.concatenate([buf.astype(x.dtype), x], axis=1)
    y = xp[:, 0:L] * w[0]
    for i in range(1, CONV_W):
        y = y + xp[:, i:i + L] * w[i]
    return y, xp[:, -(CONV_W - 1):]


def gated_delta_rule(q, k, v, beta, g, s0):
    B, L, H, Dk = q.shape
    Dv = v.shape[-1]
    C = CHUNK if L % CHUNK == 0 else L
    n = L // C

    def blk(t):
        t = t.reshape((B, n, C, H) + t.shape[3:])
        return jnp.moveaxis(t, 3, 1)

    q, k, v, beta, g = blk(q), blk(k), blk(v), blk(beta), blk(g)
    gc = jnp.cumsum(g, axis=-1)
    diff = gc[..., :, None] - gc[..., None, :]
    idx = jnp.arange(C)
    incl = idx[:, None] >= idx[None, :]
    strict = idx[:, None] > idx[None, :]
    dec_incl = jnp.exp(jnp.where(incl, diff, -jnp.inf))
    dec_strict = jnp.where(strict, dec_incl, 0.0)
    kb = k * beta[..., None]
    a = jnp.einsum('bhnid,bhnjd->bhnij', kb, k) * dec_strict
    lmat = a + jnp.eye(C, dtype=a.dtype)
    rhs = jnp.concatenate([v * beta[..., None], kb * jnp.exp(gc)[..., None]], axis=-1)
    sol = lax.linalg.triangular_solve(lmat, rhs, left_side=True, lower=True, unit_diagonal=True)
    u_c, w_c = sol[..., :Dv], sol[..., Dv:]
    attn = jnp.einsum('bhnid,bhnjd->bhnij', q, k) * dec_incl
    qg = q * jnp.exp(gc)[..., None]
    kg = k * jnp.exp(gc[..., -1:] - gc)[..., None]
    glast = jnp.exp(gc[..., -1])
    xs = (jnp.moveaxis(u_c, 2, 0), jnp.moveaxis(w_c, 2, 0), jnp.moveaxis(attn, 2, 0),
          jnp.moveaxis(qg, 2, 0), jnp.moveaxis(kg, 2, 0), jnp.moveaxis(glast, 2, 0))

    def step(s, inp):
        u_i, w_i, attn_i, qg_i, kg_i, gl_i = inp
        v_new = u_i - jnp.einsum('bhck,bhkv->bhcv', w_i, s)
        o = jnp.einsum('bhck,bhkv->bhcv', qg_i, s) + jnp.einsum('bhij,bhjv->bhiv', attn_i, v_new)
        s = s * gl_i[..., None, None] + jnp.einsum('bhck,bhcv->bhkv', kg_i, v_new)
        return s, o

    s_fin, o = lax.scan(step, s0, xs)
    o = jnp.transpose(o, (1, 0, 3, 2, 4)).reshape(B, L, H, Dv)
    return o, s_fin


def mixer(h, conv_buf, s0, w_in, sgu_norm_g, sgu_w, sgu_b, conv_w, dt_bias, a_log, dn_norm_g, w_out):
    B, L, _ = h.shape
    p = h @ w_in
    o1 = 2 * SGU_WIDTH
    o2 = o1 + CONV_CH
    o3 = o2 + DN_WIDTH
    uv, qkv, z, ab = p[..., :o1], p[..., o1:o2], p[..., o2:o3], p[..., o3:]
    uv = jax.nn.gelu(uv)
    u, v = uv[..., :SGU_WIDTH], uv[..., SGU_WIDTH:]
    v = rmsnorm(v, sgu_norm_g)
    a_out = spatial_gating(u, v, sgu_w, sgu_b)
    qkv, new_buf = causal_conv(qkv, conv_buf, conv_w)
    qkv = jax.nn.silu(qkv).reshape(B, L, 3 * DN_HEADS, DN_HEAD_DIM)
    q = l2norm(qkv[:, :, :DN_HEADS]) * (DN_HEAD_DIM ** -0.5)
    k = l2norm(qkv[:, :, DN_HEADS:2 * DN_HEADS])
    vv = qkv[:, :, 2 * DN_HEADS:].astype(jnp.float32)
    abf = ab.astype(jnp.float32)
    beta = jax.nn.sigmoid(abf[..., :DN_HEADS])
    g = -jnp.exp(a_log.astype(jnp.float32)) * jax.nn.softplus(abf[..., DN_HEADS:] + dt_bias.astype(jnp.float32))
    o, s_new = gated_delta_rule(q, k, vv, beta, g, s0.astype(jnp.float32))
    zf = jax.nn.silu(z.astype(jnp.float32)).reshape(B, L, DN_HEADS, DN_HEAD_DIM)
    b_out = (rmsnorm(o, dn_norm_g) * zf).astype(h.dtype).reshape(B, L, DN_WIDTH)
    out = jnp.concatenate([a_out, b_out], axis=-1) @ w_out
    return out, new_buf, s_new, v


def trunk(x, c, conv_state, delta_state, ada_w, ada_b, norm_mix_g, norm_ffn_g, w_in, sgu_norm_g,
          sgu_w, sgu_b, conv_w, dt_bias, a_log, dn_norm_g, w_out, w_up, w_down, final_norm_g):
    convs, deltas, vrows = [], [], []
    cs = jax.nn.silu(c)
    for l in range(DEPTH):
        mod = (cs @ ada_w[l] + ada_b[l])[:, None, :]
        sh1, sc1, gt1, sh2, sc2, gt2 = jnp.split(mod, 6, axis=-1)
        h = rmsnorm(x, norm_mix_g[l]) * (1 + sc1) + sh1
        m, nb, ns, vr = mixer(h, conv_state[l], delta_state[l], w_in[l], sgu_norm_g[l], sgu_w[l], sgu_b[l],
                              conv_w[l], dt_bias[l], a_log[l], dn_norm_g[l], w_out[l])
        x = x + gt1 * m
        h = rmsnorm(x, norm_ffn_g[l]) * (1 + sc2) + sh2
        x = x + gt2 * (jnp.square(jax.nn.relu(h @ w_up[l])) @ w_down[l])
        convs.append(nb)
        deltas.append(ns.astype(x.dtype))
        vrows.append(vr)
    y = rmsnorm(x, final_norm_g)
    return y, jnp.stack(convs), jnp.stack(deltas), jnp.stack(vrows)


def setup_inputs(seed: int = 0) -> dict:
    key = jax.random.key(seed)
    ks = jax.random.split(key, 24)
    f32 = jnp.float32
    nrm = lambda k, s, sc: jax.random.normal(k, s, f32) * sc
    dt = jnp.exp(jax.random.uniform(ks[15], (DEPTH, DN_HEADS), f32, np.log(1e-3), np.log(1e-1)))
    return {
        "x_prompt": nrm(ks[0], (BATCH, SEQ, D_MODEL), 1.0),
        "x_sample": nrm(ks[1], (DEC_BATCH, DEC_SEQ, D_MODEL), 1.0),
        "c_prompt": nrm(ks[2], (BATCH, D_MODEL), 1.0),
        "c_sample": nrm(ks[3], (DEC_BATCH, D_MODEL), 1.0),
        "state_conv": nrm(ks[4], (DEPTH, DEC_BATCH, CONV_W - 1, CONV_CH), 1.0),
        "state_delta": nrm(ks[5], (DEPTH, DEC_BATCH, DN_HEADS, DN_HEAD_DIM, DN_HEAD_DIM), 0.1),
        "ada_w": nrm(ks[6], (DEPTH, D_MODEL, 6 * D_MODEL), D_MODEL ** -0.5),
        "ada_b": nrm(ks[7], (DEPTH, 6 * D_MODEL), 0.02),
        "norm_mix_g": 1.0 + nrm(ks[8], (DEPTH, D_MODEL), 0.02),
        "norm_ffn_g": 1.0 + nrm(ks[9], (DEPTH, D_MODEL), 0.02),
        "w_in": nrm(ks[10], (DEPTH, D_MODEL, IN_WIDTH), D_MODEL ** -0.5),
        "sgu_norm_g": 1.0 + nrm(ks[11], (DEPTH, SGU_WIDTH), 0.02),
        "sgu_w": nrm(ks[12], (DEPTH, SGU_GROUPS, SGU_CHUNK, SGU_CHUNK), SGU_CHUNK ** -0.5),
        "sgu_b": nrm(ks[13], (DEPTH, SGU_GROUPS, SGU_CHUNK), 0.02),
        "conv_w": nrm(ks[14], (DEPTH, CONV_W, CONV_CH), CONV_W ** -0.5),
        "dt_bias": dt + jnp.log(-jnp.expm1(-dt)),
        "a_log": jnp.log(jax.random.uniform(ks[16], (DEPTH, DN_HEADS), f32, 1.0, 16.0)),
        "dn_norm_g": 1.0 + nrm(ks[17], (DEPTH, DN_HEAD_DIM), 0.02),
        "w_out": nrm(ks[18], (DEPTH, MIX_WIDTH, D_MODEL), MIX_WIDTH ** -0.5),
        "w_up": nrm(ks[19], (DEPTH, D_MODEL, D_FF), D_MODEL ** -0.5),
        "w_down": nrm(ks[20], (DEPTH, D_FF, D_MODEL), D_FF ** -0.5),
        "final_norm_g": 1.0 + nrm(ks[21], (D_MODEL,), 0.02),
    }


def reference(x_prompt, x_sample, c_prompt, c_sample, state_conv, state_delta, ada_w, ada_b, norm_mix_g,
              norm_ffn_g, w_in, sgu_norm_g, sgu_w, sgu_b, conv_w, dt_bias, a_log, dn_norm_g, w_out, w_up,
              w_down, final_norm_g):
    conv0 = jnp.zeros((DEPTH, x_prompt.shape[0], CONV_W - 1, CONV_CH), x_prompt.dtype)
    delta0 = jnp.zeros((DEPTH, x_prompt.shape[0], DN_HEADS, DN_HEAD_DIM, DN_HEAD_DIM), jnp.float32)
    y_prompt, prompt_conv, prompt_delta, _ = trunk(
        x_prompt, c_prompt, conv0, delta0, ada_w, ada_b, norm_mix_g, norm_ffn_g, w_in, sgu_norm_g,
        sgu_w, sgu_b, conv_w, dt_bias, a_log, dn_norm_g, w_out, w_up, w_down, final_norm_g)
    y_sample, sample_conv, sample_delta, sample_sgu_v = trunk(
        x_sample, c_sample, state_conv, state_delta, ada_w, ada_b, norm_mix_g, norm_ffn_g, w_in, sgu_norm_g,
        sgu_w, sgu_b, conv_w, dt_bias, a_log, dn_norm_g, w_out, w_up, w_down, final_norm_g)
    return (y_prompt, y_sample, prompt_conv, prompt_delta, sample_conv, sample_delta, sample_sgu_v)
```

```cpp
#include <hip/hip_runtime.h>
#include <hip/hip_cooperative_groups.h>
#include <cstdio>
#include <cstdint>
namespace cg = cooperative_groups;
namespace pg8 {
#define PG8_LAS __attribute__((address_space(3)))
typedef unsigned short bf16_t;
typedef short bf16x8 __attribute__((ext_vector_type(8)));
typedef float f32x4 __attribute__((ext_vector_type(4)));
typedef unsigned u32x4 __attribute__((ext_vector_type(4)));
constexpr int BM = 256, BK = 64, HALF = 128, HTB = HALF * BK * 2  , STAGE_BYTES = 8 * HTB, NXCD = 8, WGM = 8;

__host__ __device__ __forceinline__ int lds_byte(int r, int c) { const int st = (r >> 4) * 2 + (c >> 5), rr = r & 15, cc = c & 31, ob = rr * 64 + cc * 2; return st * 1024 + (ob ^ (((ob >> 9) & 1) << 5)); }
__host__ __device__ __forceinline__ void stage_rc(int b, int& R, int& C) { const int st = b / 1024, sb = b % 1024, swz = sb ^ (((sb >> 9) & 1) << 5); R = (st >> 1) * 16 + swz / 64; C = (st & 1) * 32 + (swz % 64) / 2; }
__host__ __device__ __forceinline__ int perm32(int rho) { const int n = rho >> 4, i = rho & 15; return 8 * (i >> 2) + 4 * n + (i & 3); }

struct Unit { int pm, pn; };
struct Gemm { const bf16_t* A; const bf16_t* Bt; int M, N, K; };

struct StaticOrder {
    int nM, nN, nwg, G, c;
    __host__ __device__ void init(int M, int N, int G_, int c_) { nM = M / BM; nN = N / BM; nwg = nM * nN; G = G_; c = c_; }
    __host__ __device__ bool next(int i, Unit& u) const {
        const long L = (long)i * G + c; if (L >= nwg) return false;
        int wgid = (int)L; { const int q = nwg / NXCD, r = nwg % NXCD, xcd = wgid % NXCD, off = wgid / NXCD; wgid = (xcd < r ? xcd * (q + 1) : r * (q + 1) + (xcd - r) * q) + off; }
        const int nig = WGM * nN, gid = wgid / nig, fm = gid * WGM, gsz = (nM - fm) < WGM ? (nM - fm) : WGM;
        u.pm = fm + ((wgid % nig) % gsz); u.pn = (wgid % nig) / gsz; return true;
    }
    __device__ __forceinline__ void a_ready(const Unit&) const {}
    __device__ __forceinline__ void done(const Unit&) const {}
};
__device__ __forceinline__ unsigned cvt_pk_bf16(float lo, float hi) { unsigned r; asm volatile("v_cvt_pk_bf16_f32 %0, %1, %2" : "=v"(r) : "v"(lo), "v"(hi)); return r; }
typedef float f32x2 __attribute__((ext_vector_type(2)));
template <class Epi, class Sched, bool ALIGN_EPI = false, bool SP2 = false>
__device__ __forceinline__ void gemm_phase(PG8_LAS unsigned char* lds, const Gemm g, const Sched& S, const Epi& E) {
    int tid_ = threadIdx.x; asm volatile("" : "+v"(tid_));
    const int tid = tid_, wid = __builtin_amdgcn_readfirstlane(tid >> 6), lane = tid & 63, wr = wid >> 2, wc = wid & 3, fr = lane & 15, fq = lane >> 4;
    const int K = g.K, nt = K / BK;
    unsigned voffA[2], voffB[2];
#pragma unroll
    for (int i = 0; i < 2; ++i) { int R, C; stage_rc(tid * 16 + i * 8192, R, C); const int Rb = Epi::PERM ? ((R & ~31) + perm32(R & 31)) : R;
        voffA[i] = (unsigned)(R * K + C) * 2u; voffB[i] = (unsigned)(Rb * K + C) * 2u; }
    const size_t kstep = (size_t)(BK * 2);
    const size_t hstep = (size_t)HALF * K * 2;
    const size_t tstep = 2 * hstep;
    const unsigned ldsw = (unsigned)wid * 1024u;
    const int aoff = lds_byte(wr * 64 + fr, fq * 8), boff = lds_byte(wc * 32 + fr, fq * 8);
#define PG8_SA(b, h) (((b) * 2 + (h)) * HTB)
#define PG8_SB(b, h) ((4 + (b) * 2 + (h)) * HTB)
#define PG8_STAGE(bufoff, gbase, voff) do { _Pragma("unroll") for (int _i = 0; _i < 2; ++_i) \
        __builtin_amdgcn_global_load_lds((const unsigned*)((const char*)(gbase) + (voff)[_i]), (PG8_LAS unsigned*)(lds + (bufoff) + ldsw + _i * 8192), 16, 0, 0); } while (0)
#define PG8_LDA(dst, b, h) do { _Pragma("unroll") for (int m = 0; m < 4; ++m) _Pragma("unroll") for (int k = 0; k < 2; ++k) dst[m][k] = *(const PG8_LAS bf16x8*)(lds + PG8_SA(b, h) + aoff + m * 2048 + k * 1024); } while (0)
#define PG8_LDB(dst, b, h) do { _Pragma("unroll") for (int n = 0; n < 2; ++n) _Pragma("unroll") for (int k = 0; k < 2; ++k) dst[n][k] = *(const PG8_LAS bf16x8*)(lds + PG8_SB(b, h) + boff + n * 2048 + k * 1024); } while (0)
#define PG8_MMA(ai, bj, At, Bt) do { __builtin_amdgcn_s_setprio(1); _Pragma("unroll") for (int m = 0; m < 4; ++m) _Pragma("unroll") for (int n = 0; n < 2; ++n) _Pragma("unroll") for (int k = 0; k < 2; ++k) \
        acc[ai][bj][m][n] = __builtin_amdgcn_mfma_f32_16x16x32_bf16(Bt[n][k], At[m][k], acc[ai][bj][m][n], 0, 0, 0); __builtin_amdgcn_s_setprio(0); } while (0)
#define PG8_WAIT_V(n) asm volatile("s_waitcnt vmcnt(" #n ")" ::: "memory")
#define PG8_WAIT_L(n) asm volatile("s_waitcnt lgkmcnt(" #n ")" ::: "memory")
#define PG8_BAR __builtin_amdgcn_s_barrier()
#define PG8_SCHED __builtin_amdgcn_sched_barrier(0)
    Unit cur, nxt; int ui = 0;
    if (!S.next(0, cur)) return;
    f32x4 acc[2][2][4][2];
#pragma unroll
    for (int a = 0; a < 2; ++a)
#pragma unroll
        for (int b = 0; b < 2; ++b)
#pragma unroll
            for (int m = 0; m < 4; ++m)
#pragma unroll
                for (int n = 0; n < 2; ++n) acc[a][b][m][n] = (f32x4){0.f, 0.f, 0.f, 0.f};
    bf16x8 At[4][2], B0[2][2], B1[2][2];
    const char* cA = (const char*)g.A + (size_t)cur.pm * tstep; const char* cB = (const char*)g.Bt + (size_t)cur.pn * tstep;
    S.a_ready(cur);
    if constexpr (SP2) {
        PG8_STAGE(PG8_SB(0, 0), cB, voffB); PG8_STAGE(PG8_SB(0, 1), cB + hstep, voffB); PG8_STAGE(PG8_SA(0, 0), cA, voffA); PG8_STAGE(PG8_SA(0, 1), cA + hstep, voffA);
        if (wr == 1) PG8_BAR;
        PG8_WAIT_V(2); PG8_BAR;
        PG8_STAGE(PG8_SB(1, 0), cB + kstep, voffB); PG8_STAGE(PG8_SA(1, 0), cA + kstep, voffA); PG8_STAGE(PG8_SB(1, 1), cB + hstep + kstep, voffB);
        PG8_WAIT_V(6); PG8_BAR;
    } else {
        PG8_STAGE(PG8_SB(0, 0), cB, voffB); PG8_STAGE(PG8_SA(0, 0), cA, voffA); PG8_STAGE(PG8_SB(0, 1), cB + hstep, voffB); PG8_STAGE(PG8_SA(0, 1), cA + hstep, voffA);
        if (wr == 1) PG8_BAR;
        PG8_WAIT_V(4); PG8_BAR;
        PG8_STAGE(PG8_SB(1, 0), cB + kstep, voffB); PG8_STAGE(PG8_SA(1, 0), cA + kstep, voffA); PG8_STAGE(PG8_SB(1, 1), cB + hstep + kstep, voffB);
        PG8_WAIT_V(6); PG8_BAR;
    }
    for (;;) {
        const bool has_next = S.next(ui + 1, nxt);
        const char* nA = has_next ? (const char*)g.A + (size_t)nxt.pm * tstep : cA; const char* nB = has_next ? (const char*)g.Bt + (size_t)nxt.pn * tstep : cB;
        for (int t = 0; t < nt; t += 2) {
            const bool last = (t == nt - 2);
            const char* a1 = cA + (size_t)(t + 1) * kstep;
            const char* a2 = last ? nA : cA + (size_t)(t + 2) * kstep; const char* b2 = last ? nB : cB + (size_t)(t + 2) * kstep;
            const char* a3 = a2 + kstep; const char* b3 = b2 + kstep;
            if (last && has_next) S.a_ready(nxt);
            if constexpr (SP2) {
            PG8_LDB(B0, 0, 0); PG8_LDB(B1, 0, 1); PG8_SCHED; PG8_LDA(At, 0, 0); PG8_STAGE(PG8_SA(1, 1), a1 + hstep, voffA);
            PG8_WAIT_V(8); PG8_WAIT_L(0); PG8_BAR; PG8_MMA(0, 0, At, B0); PG8_MMA(0, 1, At, B1); PG8_BAR; PG8_SCHED;
            PG8_LDA(At, 0, 1); PG8_STAGE(PG8_SB(0, 0), b2, voffB); PG8_STAGE(PG8_SB(0, 1), b2 + hstep, voffB); PG8_STAGE(PG8_SA(0, 0), a2, voffA);
            PG8_WAIT_V(8); PG8_WAIT_L(0); PG8_BAR; PG8_MMA(1, 0, At, B0); PG8_MMA(1, 1, At, B1); PG8_BAR; PG8_SCHED;
            PG8_LDB(B0, 1, 0); PG8_LDB(B1, 1, 1); PG8_SCHED; PG8_LDA(At, 1, 0); PG8_STAGE(PG8_SA(0, 1), a2 + hstep, voffA);
            PG8_WAIT_V(8); PG8_WAIT_L(0); PG8_BAR; PG8_MMA(0, 0, At, B0); PG8_MMA(0, 1, At, B1); PG8_BAR; PG8_SCHED;
            PG8_LDA(At, 1, 1); PG8_STAGE(PG8_SB(1, 0), b3, voffB); PG8_STAGE(PG8_SB(1, 1), b3 + hstep, voffB); PG8_STAGE(PG8_SA(1, 0), a3, voffA);
            PG8_WAIT_V(8); PG8_WAIT_L(0); PG8_BAR; PG8_MMA(1, 0, At, B0); PG8_MMA(1, 1, At, B1); PG8_BAR; PG8_SCHED;
            } else {
            PG8_LDB(B0, 0, 0); PG8_SCHED; PG8_LDA(At, 0, 0); PG8_STAGE(PG8_SA(1, 1), a1 + hstep, voffA);
            PG8_WAIT_L(8); PG8_BAR; PG8_WAIT_L(0); PG8_MMA(0, 0, At, B0); PG8_BAR; PG8_SCHED;
            PG8_LDB(B1, 0, 1); PG8_STAGE(PG8_SB(0, 0), b2, voffB);
            PG8_BAR; PG8_WAIT_L(0); PG8_MMA(0, 1, At, B1); PG8_BAR;
            PG8_LDA(At, 0, 1); PG8_STAGE(PG8_SA(0, 0), a2, voffA);
            PG8_BAR; PG8_WAIT_L(0); PG8_MMA(1, 0, At, B0); PG8_BAR; PG8_SCHED;
            PG8_STAGE(PG8_SB(0, 1), b2 + hstep, voffB);
            PG8_WAIT_V(6); PG8_BAR; PG8_MMA(1, 1, At, B1); PG8_BAR;
            PG8_LDB(B0, 1, 0); PG8_SCHED; PG8_LDA(At, 1, 0); PG8_STAGE(PG8_SA(0, 1), a2 + hstep, voffA);
            PG8_WAIT_L(8); PG8_BAR; PG8_WAIT_L(0); PG8_MMA(0, 0, At, B0); PG8_BAR; PG8_SCHED;
            PG8_LDB(B1, 1, 1); PG8_STAGE(PG8_SB(1, 0), b3, voffB);
            PG8_BAR; PG8_WAIT_L(0); PG8_MMA(0, 1, At, B1); PG8_BAR;
            PG8_LDA(At, 1, 1); PG8_STAGE(PG8_SA(1, 0), a3, voffA);
            PG8_BAR; PG8_WAIT_L(0); PG8_MMA(1, 0, At, B0); PG8_BAR; PG8_SCHED;
            PG8_STAGE(PG8_SB(1, 1), b3 + hstep, voffB);
            PG8_WAIT_V(6); PG8_BAR; PG8_MMA(1, 1, At, B1); PG8_BAR;
            }
        }
        if constexpr (ALIGN_EPI) { if (wr == 0) PG8_BAR; }
        if constexpr (!Epi::AFTER_DRAIN) { E(acc, cur, wr, wc, fr, fq); S.done(cur); }
        if (!has_next) break;
#pragma unroll
        for (int a = 0; a < 2; ++a)
#pragma unroll
            for (int b = 0; b < 2; ++b)
#pragma unroll
                for (int m = 0; m < 4; ++m)
#pragma unroll
                    for (int n = 0; n < 2; ++n) acc[a][b][m][n] = (f32x4){0.f, 0.f, 0.f, 0.f};
        cur = nxt; cA = nA; cB = nB; ++ui;
        if constexpr (ALIGN_EPI) { if (wr == 1) PG8_BAR; }
    }
    PG8_WAIT_V(0);
    if constexpr (!ALIGN_EPI) { if (wr == 0) PG8_BAR; }
    PG8_BAR;
    if constexpr (Epi::AFTER_DRAIN) { E.fused(acc, cur, wr, wc, fr, fq, lds, wid, lane); S.done(cur); }
#undef PG8_SA
#undef PG8_SB
#undef PG8_STAGE
#undef PG8_LDA
#undef PG8_LDB
#undef PG8_MMA
#undef PG8_WAIT_V
#undef PG8_WAIT_L
#undef PG8_BAR
#undef PG8_SCHED
}
}


#define LAS __attribute__((address_space(3)))
using pg8::bf16_t; using pg8::bf16x8; using pg8::f32x4;
typedef unsigned u32x2 __attribute__((ext_vector_type(2)));
typedef unsigned u32x4 __attribute__((ext_vector_type(4)));

constexpr int TP = 16384, TS = 256, TT = TP + TS;
constexpr int NSLOT = 1056;
constexpr size_t MiB = 1u << 20;
constexpr size_t W_LAYER = 24 * MiB, W_IN = 0, W_OUT = 6 * MiB, W_UP = 8 * MiB, W_DOWN = 16 * MiB;
constexpr size_t WS_ACT = 48 * MiB;
constexpr size_t WS_A = WS_ACT + (size_t)TT * 1024 * 2;
constexpr size_t WS_UC = WS_A + (size_t)TT * 3072 * 2;
constexpr size_t SLOT16 = (size_t)NSLOT * 8192 * 2;
constexpr size_t WS_WC = WS_UC + SLOT16;
constexpr size_t WS_B = WS_WC + SLOT16;
constexpr size_t WS_QG = WS_B, WS_KGT = WS_QG + SLOT16, WS_ATT = WS_KGT + SLOT16;
constexpr size_t WS_MOD = WS_ATT + (size_t)NSLOT * 4096 * 2;
constexpr size_t WS_BG = WS_MOD + 2 * 16 * 6144 * 4;
constexpr size_t WS_GL = WS_BG + (size_t)TT * 8 * 4;
constexpr size_t WS_BAR = (WS_GL + NSLOT * 4 + 511) / 256 * 256;
constexpr size_t WS_END = WS_BAR + 3456 * 4 + 256;
static_assert(WS_A + (size_t)TT * 4096 * 2 <= WS_B, "hidden overlay");
static_assert(WS_B + (size_t)TT * 1024 * 2 <= WS_ATT, "hbuf overlay");
static_assert(WS_END <= 256 * MiB, "ws");
constexpr size_t O_YS = (size_t)TP * 1024, O_PCONV = O_YS + (size_t)TS * 1024, O_PDELTA = O_PCONV + 2 * 8 * 3 * 1536,
                 O_SCONV = O_PDELTA + 2 * 8 * 4 * 128 * 128, O_SDELTA = O_SCONV + 2 * 8 * 3 * 1536, O_SGUV = O_SDELTA + 2 * 8 * 4 * 128 * 128,
                 O_END = O_SGUV + 2 * 8 * 32 * 512;
constexpr int LDS_BYTES = 156 * 1024;

struct Params { const float* in[22]; float* out; unsigned char* ws; int ph_lo, ph_hi; };

typedef __bf16 hwbf2 __attribute__((ext_vector_type(2)));
typedef float f32x2_t __attribute__((ext_vector_type(2)));
__device__ __forceinline__ unsigned pk2(float lo, float hi) { const f32x2_t v = {lo, hi}; return __builtin_bit_cast(unsigned, __builtin_convertvector(v, hwbf2)); }
__device__ __forceinline__ unsigned short f2bf(float f) { return (unsigned short)(pk2(f, 0.f) & 0xffffu); }
__device__ __forceinline__ float bf2f(unsigned short b) { return __uint_as_float(((unsigned)b) << 16); }
__device__ __forceinline__ float bflo(unsigned w) { return __uint_as_float(w << 16); }
__device__ __forceinline__ float bfhi(unsigned w) { return __uint_as_float(w & 0xffff0000u); }
__device__ __forceinline__ float wave_sum(float v) {
#pragma unroll
    for (int o = 32; o >= 1; o >>= 1) v += __shfl_xor(v, o);
    return v; }
__device__ __forceinline__ float silu_f(float x) { return x * __builtin_amdgcn_rcpf(1.f + __expf(-x)); }
__device__ __forceinline__ float sigmoid_f(float x) { return __builtin_amdgcn_rcpf(1.f + __expf(-x)); }
__device__ __forceinline__ float gelu_tanh(float x) { return x * __builtin_amdgcn_rcpf(1.f + __expf(-1.5957691216f * (x + 0.044715f * x * x * x))); }
__device__ __forceinline__ int row_tb(int r) { return r < TP ? (r >> 11) : 8 + ((r - TP) >> 5); }
__device__ __forceinline__ bf16x8 mk8(unsigned a, unsigned b, unsigned c, unsigned d) { u32x4 v = {a, b, c, d}; return __builtin_bit_cast(bf16x8, v); }
__device__ __forceinline__ int tid_l() { int t = threadIdx.x; asm volatile("" : "+v"(t)); return t; }
__device__ __forceinline__ int bid_l() { int t = blockIdx.x; asm volatile("" : "+s"(t)); return t; }
#define MFMA16(a, b, c) __builtin_amdgcn_mfma_f32_16x16x32_bf16((a), (b), (c), 0, 0, 0)

struct EpiP {
    static constexpr bool PERM = true, AFTER_DRAIN = false;
    bf16_t* O;
    __device__ __forceinline__ void operator()(const f32x4 (&acc)[2][2][4][2], const pg8::Unit& u, int wr, int wc, int fr, int fq) const {
        const int row0 = u.pm * 256 + wr * 64 + fr, col0 = u.pn * 256 + wc * 32 + 8 * fq; const bool act = u.pn < 4, zact = u.pn >= 10;
#pragma unroll
        for (int ai = 0; ai < 2; ++ai)
#pragma unroll
            for (int m = 0; m < 4; ++m) { bf16_t* rowp = O + (size_t)(row0 + ai * 128 + m * 16) * 3072 + col0;
#pragma unroll
                for (int bj = 0; bj < 2; ++bj) { f32x4 v0 = acc[ai][bj][m][0], v1 = acc[ai][bj][m][1];
                    if (act) {
#pragma unroll
                        for (int j = 0; j < 4; ++j) { v0[j] = gelu_tanh(v0[j]); v1[j] = gelu_tanh(v1[j]); } }
                    if (zact) {
#pragma unroll
                        for (int j = 0; j < 4; ++j) { v0[j] = silu_f(v0[j]); v1[j] = silu_f(v1[j]); } }
                    u32x4 w; w.x = pg8::cvt_pk_bf16(v0[0], v0[1]); w.y = pg8::cvt_pk_bf16(v0[2], v0[3]); w.z = pg8::cvt_pk_bf16(v1[0], v1[1]); w.w = pg8::cvt_pk_bf16(v1[2], v1[3]);
                    *(u32x4*)(rowp + bj * 128) = w; } }
    }
    __device__ __forceinline__ void row8(int r, int c, const float (&v)[8]) const {
        float t[8];
#pragma unroll
        for (int j = 0; j < 8; ++j) t[j] = c < 1024 ? gelu_tanh(v[j]) : (c >= 2560 ? silu_f(v[j]) : v[j]);
        u32x4 w; w.x = pk2(t[0], t[1]); w.y = pk2(t[2], t[3]); w.z = pk2(t[4], t[5]); w.w = pk2(t[6], t[7]);
        *(u32x4*)(O + (size_t)r * 3072 + c) = w; }
};
struct EpiH {
    static constexpr bool PERM = true, AFTER_DRAIN = false;
    bf16_t* O;
    __device__ __forceinline__ void operator()(const f32x4 (&acc)[2][2][4][2], const pg8::Unit& u, int wr, int wc, int fr, int fq) const {
        const int row0 = u.pm * 256 + wr * 64 + fr, col0 = u.pn * 256 + wc * 32 + 8 * fq;
#pragma unroll
        for (int ai = 0; ai < 2; ++ai)
#pragma unroll
            for (int m = 0; m < 4; ++m) { bf16_t* rowp = O + (size_t)(row0 + ai * 128 + m * 16) * 4096 + col0;
#pragma unroll
                for (int bj = 0; bj < 2; ++bj) { f32x4 v0 = acc[ai][bj][m][0], v1 = acc[ai][bj][m][1];
#pragma unroll
                    for (int j = 0; j < 4; ++j) { const float a = fmaxf(v0[j], 0.f), b = fmaxf(v1[j], 0.f); v0[j] = a * a; v1[j] = b * b; }
                    u32x4 w; w.x = pg8::cvt_pk_bf16(v0[0], v0[1]); w.y = pg8::cvt_pk_bf16(v0[2], v0[3]); w.z = pg8::cvt_pk_bf16(v1[0], v1[1]); w.w = pg8::cvt_pk_bf16(v1[2], v1[3]);
                    *(u32x4*)(rowp + bj * 128) = w; } }
    }
    __device__ __forceinline__ void row8(int r, int c, const float (&v)[8]) const {
        float t[8];
#pragma unroll
        for (int j = 0; j < 8; ++j) { const float a = fmaxf(v[j], 0.f); t[j] = a * a; }
        u32x4 w; w.x = pk2(t[0], t[1]); w.y = pk2(t[2], t[3]); w.z = pk2(t[4], t[5]); w.w = pk2(t[6], t[7]);
        *(u32x4*)(O + (size_t)r * 4096 + c) = w; }
};
struct EpiRes {
    static constexpr bool PERM = false, AFTER_DRAIN = false;
    const float* base_p; const float* base_s; float* out; const float* gate;
    __device__ __forceinline__ void operator()(const f32x4 (&acc)[2][2][4][2], const pg8::Unit& u, int wr, int wc, int fr, int fq) const {
        const int row0 = u.pm * 256 + wr * 64 + fr, col0 = u.pn * 256 + wc * 32 + 4 * fq;
#pragma unroll
        for (int ai = 0; ai < 2; ++ai)
#pragma unroll
            for (int m = 0; m < 4; ++m) { const int r = row0 + ai * 128 + m * 16; const int tb = row_tb(r);
                const float* bp = (r < TP) ? base_p + (size_t)r * 1024 : base_s + (size_t)(r - TP) * 1024; float* op = out + (size_t)r * 1024; const float* gp = gate + tb * 6144;
#pragma unroll
                for (int bj = 0; bj < 2; ++bj)
#pragma unroll
                    for (int n = 0; n < 2; ++n) { const int c = col0 + bj * 128 + n * 16; const f32x4 bv = *(const f32x4*)(bp + c), gv = *(const f32x4*)(gp + c);
                        *(f32x4*)(op + c) = bv + gv * acc[ai][bj][m][n]; } }
    }
    __device__ __forceinline__ void row8(int r, int c, const float (&v)[8]) const {
        const float* bp = base_s + (size_t)(r - TP) * 1024 + c; const float* gp = gate + row_tb(r) * 6144 + c; float* op = out + (size_t)r * 1024 + c;
        const f32x4 b0 = *(const f32x4*)bp, b1 = *(const f32x4*)(bp + 4), g0 = *(const f32x4*)gp, g1 = *(const f32x4*)(gp + 4);
        *(f32x4*)op = b0 + g0 * (f32x4){v[0], v[1], v[2], v[3]}; *(f32x4*)(op + 4) = b1 + g1 * (f32x4){v[4], v[5], v[6], v[7]}; }
};
template <bool ALIGN, class Epi> __device__ __forceinline__ void run_gemm(LAS unsigned char* lds, const bf16_t* A, const bf16_t* Bt, int N, int K, const Epi& E) {
    pg8::Gemm g; g.A = A; g.Bt = Bt; g.M = TP; g.N = N; g.K = K;
    pg8::StaticOrder S; S.init(TP, N, (int)gridDim.x, bid_l());
    pg8::gemm_phase<Epi, pg8::StaticOrder, ALIGN, true>(lds, g, S, E);
}
template <int TM, int TN, int UNR, class Epi> __device__ __forceinline__ void small_gemm(LAS unsigned char* lds, const bf16_t* A, const bf16_t* Bt, int N, int K, const Epi& E) {
    constexpr int MT = TM / 16, NT = TN / 16;
    const int tid = tid_l(), lane = tid & 63, wave = tid >> 6, x = lane & 15, kq = lane >> 4;
    const int ntn = N / TN, ntiles = (TS / TM) * ntn, kw = K / 8;
    LAS float* red = (LAS float*)lds;
    for (int t = bid_l(); t < ntiles; t += gridDim.x) {
        const int tm = t / ntn, tn = t - tm * ntn;
        const bf16_t* ap = A + (size_t)(TP + tm * TM + x) * K + wave * kw + kq * 8;
        const bf16_t* bp = Bt + (size_t)(tn * TN + x) * K + wave * kw + kq * 8;
        f32x4 acc[NT][MT];
#pragma unroll
        for (int nt = 0; nt < NT; ++nt)
#pragma unroll
            for (int mt = 0; mt < MT; ++mt) acc[nt][mt] = (f32x4){0.f, 0.f, 0.f, 0.f};
        for (int ks0 = 0; ks0 < kw / 32; ks0 += UNR) {
            bf16x8 af[UNR][MT], bfr[UNR][NT];
#pragma unroll
            for (int j = 0; j < UNR; ++j) {
#pragma unroll
                for (int mt = 0; mt < MT; ++mt) af[j][mt] = *(const bf16x8*)(ap + (size_t)mt * 16 * K + (ks0 + j) * 32);
#pragma unroll
                for (int nt = 0; nt < NT; ++nt) bfr[j][nt] = *(const bf16x8*)(bp + (size_t)nt * 16 * K + (ks0 + j) * 32); }
            __builtin_amdgcn_sched_barrier(0);
#pragma unroll
            for (int j = 0; j < UNR; ++j)
#pragma unroll
                for (int nt = 0; nt < NT; ++nt)
#pragma unroll
                    for (int mt = 0; mt < MT; ++mt) acc[nt][mt] = MFMA16(bfr[j][nt], af[j][mt], acc[nt][mt]);
            __builtin_amdgcn_sched_barrier(0);
        }
#pragma unroll
        for (int nt = 0; nt < NT; ++nt)
#pragma unroll
            for (int mt = 0; mt < MT; ++mt) *(LAS f32x4*)(red + wave * TM * TN + (16 * mt + x) * TN + 16 * nt + kq * 4) = acc[nt][mt];
        __syncthreads();
        if (tid < TM * TN / 8) { const int r = tid / (TN / 8), c8 = (tid % (TN / 8)) * 8; float v[8];
#pragma unroll
            for (int j = 0; j < 8; ++j) v[j] = 0.f;
#pragma unroll
            for (int w = 0; w < 8; ++w) { const f32x4 a = *(const LAS f32x4*)(red + w * TM * TN + r * TN + c8), c = *(const LAS f32x4*)(red + w * TM * TN + r * TN + c8 + 4);
                v[0] += a[0]; v[1] += a[1]; v[2] += a[2]; v[3] += a[3]; v[4] += c[0]; v[5] += c[1]; v[6] += c[2]; v[7] += c[3]; }
            E.row8(TP + tm * TM + r, tn * TN + c8, v); }
        __syncthreads();
    }
}

__device__ __forceinline__ void transpose_tile4(const float* W, int ldw, bf16_t* Bt, int ldb, int k0, int n0, LAS float* tile  ) {
    const int tid = tid_l(), ty = tid >> 6, tx = tid & 63;
    f32x4 v[8];
#pragma unroll
    for (int i = 0; i < 8; ++i) v[i] = *(const f32x4*)(W + (size_t)(k0 + ty + 8 * i) * ldw + n0 + tx * 4);
#pragma unroll
    for (int i = 0; i < 8; ++i) { const int k = ty + 8 * i; tile[k * 261 + tx * 4 + 0] = v[i][0]; tile[k * 261 + tx * 4 + 1] = v[i][1]; tile[k * 261 + tx * 4 + 2] = v[i][2]; tile[k * 261 + tx * 4 + 3] = v[i][3]; }
    __syncthreads();
#pragma unroll
    for (int i = 0; i < 4; ++i) { const int n = (tid >> 3) + 64 * i, kq = tid & 7; u32x4 w;
        w.x = pk2(tile[(kq * 8 + 0) * 261 + n], tile[(kq * 8 + 1) * 261 + n]); w.y = pk2(tile[(kq * 8 + 2) * 261 + n], tile[(kq * 8 + 3) * 261 + n]);
        w.z = pk2(tile[(kq * 8 + 4) * 261 + n], tile[(kq * 8 + 5) * 261 + n]); w.w = pk2(tile[(kq * 8 + 6) * 261 + n], tile[(kq * 8 + 7) * 261 + n]);
        *(u32x4*)(Bt + (size_t)(n0 + n) * ldb + k0 + kq * 8) = w; }
    __syncthreads();
}
__device__ __forceinline__ void phase0(const Params& P, LAS unsigned char* lds) {
    const int tid = tid_l(), lane = tid & 63, wave = tid >> 6, G = gridDim.x, bid = bid_l();
    float* mod = (float*)(P.ws + WS_MOD);
    if (bid < 192) {
        LAS float* cs = (LAS float*)lds;
        LAS float* red = (LAS float*)(lds + 65536);
        for (int i = tid; i < 16384; i += 512) { const int tb = i >> 10, k = i & 1023; const float c = tb < 8 ? P.in[2][tb * 1024 + k] : P.in[3][(tb - 8) * 1024 + k]; cs[k * 16 + tb] = silu_f(c); }
        __syncthreads();
        for (int item = bid; item < 192; item += G) {
            const int l = item / 96, cgp = item % 96, j = cgp * 64 + lane;
            const float* wp = P.in[6] + ((size_t)l * 1024 + wave * 128) * 6144 + j;
            float acc[16];
#pragma unroll
            for (int t = 0; t < 16; ++t) acc[t] = 0.f;
#pragma unroll 16
            for (int kk = 0; kk < 128; ++kk) { const float wv = wp[(size_t)kk * 6144]; const LAS f32x4* c4 = (const LAS f32x4*)(cs + (wave * 128 + kk) * 16);
#pragma unroll
                for (int q = 0; q < 4; ++q) { const f32x4 cv = c4[q]; acc[4 * q + 0] += cv[0] * wv; acc[4 * q + 1] += cv[1] * wv; acc[4 * q + 2] += cv[2] * wv; acc[4 * q + 3] += cv[3] * wv; } }
#pragma unroll
            for (int t = 0; t < 16; ++t) red[(wave * 16 + t) * 64 + lane] = acc[t];
            __syncthreads();
            for (int o = tid; o < 1024; o += 512) { const int tb = o >> 6, ln = o & 63; float s = P.in[7][l * 6144 + cgp * 64 + ln];
#pragma unroll
                for (int w = 0; w < 8; ++w) s += red[(w * 16 + tb) * 64 + ln];
                mod[(size_t)(l * 16 + tb) * 6144 + cgp * 64 + ln] = s; }
            __syncthreads();
        }
    }
    __syncthreads();
    LAS float* tile = (LAS float*)lds;
    for (int it = bid; it < 1536; it += G) {
        const int l = it / 768; int r = it % 768; const float* W; int ldw, K, kt, nt; bf16_t* Bt;
        if (r < 192) { W = P.in[10] + (size_t)l * 1024 * 3080; ldw = 3080; K = 1024; Bt = (bf16_t*)(P.ws + l * W_LAYER + W_IN); kt = r / 12; nt = r % 12; }
        else if (r < 256) { r -= 192; W = P.in[18] + (size_t)l * 1024 * 1024; ldw = 1024; K = 1024; Bt = (bf16_t*)(P.ws + l * W_LAYER + W_OUT); kt = r / 4; nt = r % 4; }
        else if (r < 512) { r -= 256; W = P.in[19] + (size_t)l * 1024 * 4096; ldw = 4096; K = 1024; Bt = (bf16_t*)(P.ws + l * W_LAYER + W_UP); kt = r / 16; nt = r % 16; }
        else { r -= 512; W = P.in[20] + (size_t)l * 4096 * 1024; ldw = 1024; K = 4096; Bt = (bf16_t*)(P.ws + l * W_LAYER + W_DOWN); kt = r / 4; nt = r % 4; }
        transpose_tile4(W, ldw, Bt, K, kt * 64, nt * 256, tile);
    }
}

template <bool MIX> __device__ __forceinline__ void phase_h(const Params& P, int l, LAS unsigned char* lds) {
    const int tid = tid_l(), lane = tid & 63, wave = tid >> 6;
    const float* gamma = (MIX ? P.in[8] : P.in[9]) + l * 1024;
    const float* mod = (const float*)(P.ws + WS_MOD) + (size_t)l * 16 * 6144;
    const int shoff = MIX ? 0 : 3072, scoff = MIX ? 1024 : 4096;
    bf16_t* hbuf = (bf16_t*)(P.ws + WS_B);
    float* bg = (float*)(P.ws + WS_BG);
    const float* wab = P.in[10] + (size_t)l * 1024 * 3080 + 3072;
    LAS float* wT = (LAS float*)lds;
    if (MIX) {
#pragma unroll
        for (int i = 0; i < 2; ++i) { const int j = tid + 512 * i; const f32x4 w0 = *(const f32x4*)(wab + (size_t)j * 3080), w1 = *(const f32x4*)(wab + (size_t)j * 3080 + 4);
            wT[j] = w0[0]; wT[1024 + j] = w0[1]; wT[2048 + j] = w0[2]; wT[3072 + j] = w0[3]; wT[4096 + j] = w1[0]; wT[5120 + j] = w1[1]; wT[6144 + j] = w1[2]; wT[7168 + j] = w1[3]; }
        __syncthreads();
    }
    const int gw = bid_l() * 8 + wave;
#define XROW(r_) ((MIX && l == 0) ? ((r_) < TP ? P.in[0] + (size_t)(r_) * 1024 : P.in[1] + (size_t)((r_) - TP) * 1024) : P.out + (size_t)(r_) * 1024)
#define LOAD_MOD(tb_) do { const float* mp_ = mod + (tb_) * 6144; _Pragma("unroll") for (int i_ = 0; i_ < 4; ++i_) { const int j_ = lane * 4 + 256 * i_; \
        const f32x4 g4_ = *(const f32x4*)(gamma + j_), sc4_ = *(const f32x4*)(mp_ + scoff + j_); csv[i_] = g4_ * (sc4_ + 1.f); shv[i_] = *(const f32x4*)(mp_ + shoff + j_); } } while (0)
    if (gw * 8 >= TP) return;
    f32x4 csv[4], shv[4], v[4];
    { const float* xr = XROW(gw * 8);
#pragma unroll
      for (int i = 0; i < 4; ++i) v[i] = *(const f32x4*)(xr + lane * 4 + 256 * i); }
    LOAD_MOD((gw * 8) >> 11);
    const int nrows = gw < TS ? 9 : 8;
    for (int it = 0; it < nrows; ++it) {
        const int r = it < 8 ? gw * 8 + it : TP + gw;
        f32x4 vnx[4];
        if (it + 1 < nrows) { const float* xn = XROW(it + 1 < 8 ? gw * 8 + it + 1 : TP + gw);
#pragma unroll
            for (int i = 0; i < 4; ++i) vnx[i] = *(const f32x4*)(xn + lane * 4 + 256 * i); }
        if (it == 8) LOAD_MOD(8 + (gw >> 5));
        float ss = 0.f;
#pragma unroll
        for (int i = 0; i < 4; ++i) ss += v[i][0] * v[i][0] + v[i][1] * v[i][1] + v[i][2] * v[i][2] + v[i][3] * v[i][3];
        ss = wave_sum(ss);
        const float rstd = rsqrtf(ss * (1.f / 1024.f) + 1e-6f);
        float ab[8];
#pragma unroll
        for (int e = 0; e < 8; ++e) ab[e] = 0.f;
#pragma unroll
        for (int i = 0; i < 4; ++i) { const int j = lane * 4 + 256 * i;
            const f32x4 hv = v[i] * rstd * csv[i] + shv[i];
            u32x2 w; w.x = pk2(hv[0], hv[1]); w.y = pk2(hv[2], hv[3]);
            *(u32x2*)(hbuf + (size_t)r * 1024 + j) = w;
            if (MIX) {
#pragma unroll
                for (int c = 0; c < 8; ++c) { const f32x4 w4 = *(const LAS f32x4*)(wT + c * 1024 + j); ab[c] += hv[0] * w4[0] + hv[1] * w4[1] + hv[2] * w4[2] + hv[3] * w4[3]; } }
        }
        if (MIX) {
            const bool h1 = lane & 32, h2 = lane & 16, h3 = lane & 8;
            float k4[4], k2[2];
#pragma unroll
            for (int i = 0; i < 4; ++i) { const float send = h1 ? ab[i] : ab[4 + i]; k4[i] = (h1 ? ab[4 + i] : ab[i]) + __shfl_xor(send, 32); }
#pragma unroll
            for (int i = 0; i < 2; ++i) { const float send = h2 ? k4[i] : k4[2 + i]; k2[i] = (h2 ? k4[2 + i] : k4[i]) + __shfl_xor(send, 16); }
            float k1 = (h3 ? k2[1] : k2[0]) + __shfl_xor(h3 ? k2[0] : k2[1], 8);
            k1 += __shfl_xor(k1, 4); k1 += __shfl_xor(k1, 2); k1 += __shfl_xor(k1, 1);
            if ((lane & 7) == 0) { const int idx = lane >> 3, h = idx & 3;
                if (idx < 4) bg[(size_t)r * 8 + h] = sigmoid_f(k1);
                else { const float xx = k1 + P.in[15][l * 4 + h]; const float sp = xx > 20.f ? xx : log1pf(expf(xx)); bg[(size_t)r * 8 + 4 + h] = -expf(P.in[16][l * 4 + h]) * sp; } }
        }
#pragma unroll
        for (int i = 0; i < 4; ++i) v[i] = vnx[i];
    }
#undef XROW
#undef LOAD_MOD
}

template <int C> struct B1Raw { static constexpr int NCH = (C + 3) * 48, NB = (NCH + 511) / 512; };
template <int C> __device__ __forceinline__ void b1_issue(const Params& P, int l, int it, int tid, u32x4 (&rv)[B1Raw<C>::NB]) {
    const bool sample = it >= 1024; const int bh = sample ? it - 1024 : it >> 5, ci = sample ? 0 : it & 31, b = bh >> 2, h = bh & 3;
    const int row0 = sample ? TP + b * 32 : b * 2048 + ci * 64; const bool first = ci == 0;
    const bf16_t* p = (const bf16_t*)(P.ws + WS_A);
#pragma unroll
    for (int i = 0; i < B1Raw<C>::NB; ++i) { const int idx = tid + 512 * i; rv[i] = (u32x4){0u, 0u, 0u, 0u};
        if (idx < B1Raw<C>::NCH) { const int rr = idx / 48, cc = idx - rr * 48, tt = rr - 3, ch = (cc >> 4) * 512 + h * 128 + (cc & 15) * 8;
            if (tt >= 0 || !first) rv[i] = *(const u32x4*)(p + (size_t)(row0 + tt) * 3072 + 1024 + ch);
            else if (sample) { const float* sp = P.in[4] + ((size_t)(l * 8 + b) * 3 + rr) * 1536 + ch; const f32x4 a = *(const f32x4*)sp, c4 = *(const f32x4*)(sp + 4);
                rv[i] = (u32x4){pk2(a[0], a[1]), pk2(a[2], a[3]), pk2(c4[0], c4[1]), pk2(c4[2], c4[3])}; } } }
}
template <int C> __device__ __forceinline__ void b1_item(const Params& P, int l, int it, int nxt, u32x4 (&rv)[B1Raw<C>::NB], LAS unsigned char* lds) {
    constexpr int NT = C / 16;
    const int tid = tid_l(), lane = tid & 63, wave = tid >> 6;
    const bool sample = it >= 1024; const int slot = it, bh = sample ? it - 1024 : it >> 5, ci = sample ? 0 : it & 31, b = bh >> 2, h = bh & 3;
    const int row0 = sample ? TP + b * 32 : b * 2048 + ci * 64; const bool last = sample || ci == 31;
    LAS float* F0 = (LAS float*)lds;
    LAS float* F1 = (LAS float*)(lds + 33792);
    LAS float* F2 = (LAS float*)(lds + 67584);
    LAS bf16_t* QB = (LAS bf16_t*)(lds + 101376);
    LAS bf16_t* KB = (LAS bf16_t*)(lds + 118784);
    LAS bf16_t* KBB = (LAS bf16_t*)(lds + 136192);
    LAS float* rn = (LAS float*)(lds + 153600);
    LAS float* betas = rn + 128;
    LAS float* gcs = betas + 64;
    LAS float* egs = gcs + 64;
    LAS float* egls = egs + 64;
    const float* bg = (const float*)(P.ws + WS_BG);
    bf16_t* UC = (bf16_t*)(P.ws + WS_UC) + (size_t)slot * 8192; bf16_t* WC = (bf16_t*)(P.ws + WS_WC) + (size_t)slot * 8192;
    bf16_t* QG = (bf16_t*)(P.ws + WS_QG) + (size_t)slot * 8192; bf16_t* KGT = (bf16_t*)(P.ws + WS_KGT) + (size_t)slot * 8192;
    bf16_t* ATT = (bf16_t*)(P.ws + WS_ATT) + (size_t)slot * 4096;
    LAS bf16_t* RAW = QB;
#pragma unroll
    for (int i = 0; i < B1Raw<C>::NB; ++i) { const int idx = tid + 512 * i; if (idx < B1Raw<C>::NCH) *(LAS u32x4*)(RAW + idx * 8) = rv[i]; }
    __syncthreads();
    if (nxt >= 0) b1_issue<C>(P, l, nxt, tid, rv);
    if (tid < 384) {
        const int c = tid, which = c >> 7, d = c & 127, ch = which * 512 + h * 128 + d;
        const float* cw = P.in[14] + (size_t)l * 4 * 1536 + ch;
        const float w0 = cw[0], w1 = cw[1536], w2 = cw[3072], w3 = cw[4608];
        LAS float* F = which == 0 ? F0 : (which == 1 ? F1 : F2);
        float x0 = bf2f(RAW[c]), x1 = bf2f(RAW[384 + c]), x2 = bf2f(RAW[768 + c]);
#pragma unroll 8
        for (int t = 0; t < C; ++t) { const float x3 = bf2f(RAW[(t + 3) * 384 + c]); F[t * 132 + d] = silu_f(w0 * x0 + w1 * x1 + w2 * x2 + w3 * x3); x0 = x1; x1 = x2; x2 = x3; }
        if (last) { float* oc = P.out + (sample ? O_SCONV : O_PCONV) + (size_t)(l * 8 + b) * 3 * 1536;
            oc[ch] = x0; oc[1536 + ch] = x1; oc[3072 + ch] = x2; }
    } else if (wave == 6) {
        float gv = lane < C ? bg[(size_t)(row0 + lane) * 8 + 4 + h] : 0.f;
#pragma unroll
        for (int dd = 1; dd < 64; dd <<= 1) { const float n = __shfl_up(gv, dd); if (lane >= dd) gv += n; }
        const float gl_ = __shfl(gv, C - 1);
        if (lane < C) { gcs[lane] = gv; betas[lane] = bg[(size_t)(row0 + lane) * 8 + h]; egs[lane] = __expf(gv); egls[lane] = __expf(gl_ - gv); }
        if (lane == 0) ((float*)(P.ws + WS_GL))[slot] = __expf(gl_);
    }
    __syncthreads();
#pragma unroll
    for (int i = 0; i < (2 * C * 8) / 512; ++i) { const int idx = tid + 512 * i, ar = idx >> 3, part = idx & 7; const LAS float* src = (ar < C ? F0 + ar * 132 : F1 + (ar - C) * 132) + part * 16; float ss = 0.f;
#pragma unroll
        for (int j = 0; j < 4; ++j) { const f32x4 v = *(const LAS f32x4*)(src + 4 * j); ss += v[0] * v[0] + v[1] * v[1] + v[2] * v[2] + v[3] * v[3]; }
        ss += __shfl_xor(ss, 1); ss += __shfl_xor(ss, 2); ss += __shfl_xor(ss, 4);
        if (part == 0) rn[ar] = rsqrtf(ss + 1e-6f) * (ar < C ? 0.08838834764831845f : 1.f); }
    __syncthreads();
#pragma unroll
    for (int i = 0; i < (C * 32) / 512; ++i) { const int idx = tid + 512 * i, t = idx >> 5, d = (idx & 31) * 4;
        const f32x4 q4 = *(const LAS f32x4*)(F0 + t * 132 + d), k4 = *(const LAS f32x4*)(F1 + t * 132 + d), v4 = *(const LAS f32x4*)(F2 + t * 132 + d);
        const float rq = rn[t], rk = rn[C + t], bt = betas[t], eg = egs[t];
        const f32x4 qn = q4 * rq, kn = k4 * rk, kbt = kn * bt;
        *(LAS u32x2*)(QB + t * 136 + d) = (u32x2){pk2(qn[0], qn[1]), pk2(qn[2], qn[3])};
        *(LAS u32x2*)(KB + t * 136 + d) = (u32x2){pk2(kn[0], kn[1]), pk2(kn[2], kn[3])};
        *(LAS u32x2*)(KBB + t * 136 + d) = (u32x2){pk2(kbt[0], kbt[1]), pk2(kbt[2], kbt[3])};
        const f32x4 qe = qn * eg; *(u32x2*)(QG + t * 128 + d) = (u32x2){pk2(qe[0], qe[1]), pk2(qe[2], qe[3])};
        *(LAS f32x4*)(F0 + t * 132 + d) = kbt * eg; *(LAS f32x4*)(F2 + t * 132 + d) = v4 * bt; }
#pragma unroll
    for (int i = 0; i < (C * 16) / 512; ++i) { const int idx = tid + 512 * i, d = idx & 127, tg = idx >> 7; float kv[8];
#pragma unroll
        for (int j = 0; j < 8; ++j) { const int t = tg * 8 + j; kv[j] = F1[t * 132 + d] * rn[C + t] * egls[t]; }
        *(u32x4*)(KGT + d * 64 + tg * 8) = (u32x4){pk2(kv[0], kv[1]), pk2(kv[2], kv[3]), pk2(kv[4], kv[5]), pk2(kv[6], kv[7])}; }
    __syncthreads();
    LAS float* AdT = F1;
    LAS bf16_t* Abf = (LAS bf16_t*)(lds + 33792 + 4352);
    LAS float* UL = (LAS float*)(lds + 33792 + 13568);
    if (wave < 2 * NT) {
        const int prod = wave / NT, ti = wave % NT, m = lane & 15, kq = lane >> 4;
        const LAS bf16_t* Asrc = prod == 0 ? KBB : QB;
        for (int tj = 0; tj < NT; ++tj) {
            if (prod == 0 && tj > ti) break;
            f32x4 acc = {0.f, 0.f, 0.f, 0.f};
            if (tj <= ti) {
#pragma unroll
                for (int s = 0; s < 4; ++s) { const bf16x8 a = *(const LAS bf16x8*)(Asrc + (16 * ti + m) * 136 + 32 * s + kq * 8), bb = *(const LAS bf16x8*)(KB + (16 * tj + m) * 136 + 32 * s + kq * 8);
                    acc = MFMA16(a, bb, acc); }
            }
            const int j = 16 * tj + m; const float gj = gcs[j];
#pragma unroll
            for (int r = 0; r < 4; ++r) { const int i = 16 * ti + kq * 4 + r; const float dec = __expf(fminf(gcs[i] - gj, 0.f));
                if (prod == 0) { const float a = (i > j) ? acc[r] * dec : 0.f;
                    if (tj == ti) AdT[(ti * 16 + m) * 16 + kq * 4 + r] = a; else Abf[i * 72 + j] = f2bf(a); }
                else ATT[i * 64 + j] = f2bf((i >= j) ? acc[r] * dec : 0.f); }
        }
    }
    __syncthreads();
    {
        LAS bf16_t* XT = QB;
        const int c = tid & 255; const LAS float* rhs = (c < 128) ? (F2 + c) : (F0 + (c - 128));
        bf16_t* dst = ((c < 128) ? UC : WC) + (c & 127);
        int zoff; asm volatile("v_mov_b32 %0, 0" : "=v"(zoff));
        const LAS float* Az = AdT + zoff * 4;
        const int m = lane & 15, kq = lane >> 4;
#pragma unroll
        for (int bk = 0; bk < NT; ++bk) {
            if (bk > 0) {
#pragma unroll
                for (int cti = 0; cti < 2; ++cti) { const int ct = wave * 2 + cti; f32x4 acc = {0.f, 0.f, 0.f, 0.f};
#pragma unroll
                    for (int s = 0; s < (bk + 1) / 2; ++s) { const bool on = (32 * s + kq * 8) < 16 * bk;
                        u32x4 xa = *(const LAS u32x4*)(XT + (16 * ct + m) * 72 + 32 * s + kq * 8), ab = *(const LAS u32x4*)(Abf + (16 * bk + m) * 72 + 32 * s + kq * 8);
                        if (!on) { xa = (u32x4){0u, 0u, 0u, 0u}; ab = (u32x4){0u, 0u, 0u, 0u}; }
                        acc = MFMA16(__builtin_bit_cast(bf16x8, xa), __builtin_bit_cast(bf16x8, ab), acc); }
                    *(LAS f32x4*)(UL + m * 260 + 16 * ct + kq * 4) = acc; }
                __syncthreads();
            }
            if (tid < 256) {
                float x[16];
#pragma unroll
                for (int i = 0; i < 16; ++i) x[i] = rhs[(16 * bk + i) * 132] - (bk > 0 ? UL[i * 260 + c] : 0.f);
#pragma unroll
                for (int j = 0; j < 15; ++j)
#pragma unroll
                    for (int i = j + 1; i < 16; ++i) x[i] -= Az[(bk * 16 + j) * 16 + i] * x[j];
                const u32x4 w0 = {pk2(x[0], x[1]), pk2(x[2], x[3]), pk2(x[4], x[5]), pk2(x[6], x[7])}, w1 = {pk2(x[8], x[9]), pk2(x[10], x[11]), pk2(x[12], x[13]), pk2(x[14], x[15])};
                *(LAS u32x4*)(XT + c * 72 + 16 * bk) = w0; *(LAS u32x4*)(XT + c * 72 + 16 * bk + 8) = w1;
                if (c < 128) {
                    bf16_t* uf = UC + ((((c >> 4) * 4 + bk) * 64) + (c & 15)) * 4;
                    *(u32x2*)(uf) = (u32x2){w0[0], w0[1]}; *(u32x2*)(uf + 64) = (u32x2){w0[2], w0[3]}; *(u32x2*)(uf + 128) = (u32x2){w1[0], w1[1]}; *(u32x2*)(uf + 192) = (u32x2){w1[2], w1[3]};
                } else {
#pragma unroll
                    for (int i = 0; i < 4; ++i) { dst[(16 * bk + 2 * i) * 128] = (bf16_t)(w0[i] & 0xffffu); dst[(16 * bk + 2 * i + 1) * 128] = (bf16_t)(w0[i] >> 16);
                        dst[(16 * bk + 8 + 2 * i) * 128] = (bf16_t)(w1[i] & 0xffffu); dst[(16 * bk + 8 + 2 * i + 1) * 128] = (bf16_t)(w1[i] >> 16); } }
            }
            __syncthreads();
        }
    }
}
__device__ __forceinline__ void phase_b1(const Params& P, int l, LAS unsigned char* lds) {
    const int tid = tid_l(), G = gridDim.x; int it = bid_l();
    {
        u32x4 rv[B1Raw<64>::NB];
        if (it < 1024) b1_issue<64>(P, l, it, tid, rv);
        for (; it < 1024; it += G) { const int nx = it + G; b1_item<64>(P, l, it, nx < 1024 ? nx : -1, rv, lds); }
    }
    for (; it < NSLOT; it += G) { u32x4 rs[B1Raw<32>::NB]; b1_issue<32>(P, l, it, tid, rs); b1_item<32>(P, l, it, -1, rs, lds); }
}

__device__ __forceinline__ bf16x8 ldA(const LAS bf16_t* X, int ld, int row, int s, int kq) {
    const u32x2 lo = *(const LAS u32x2*)(X + row * ld + 32 * s + kq * 4), hi = *(const LAS u32x2*)(X + row * ld + 32 * s + 16 + kq * 4);
    return mk8(lo.x, lo.y, hi.x, hi.y); }
__device__ __forceinline__ bf16x8 packB(const f32x4& a, const f32x4& b) { return mk8(pk2(a[0], a[1]), pk2(a[2], a[3]), pk2(b[0], b[1]), pk2(b[2], b[3])); }
template <int C> __device__ __forceinline__ void scan_job(const Params& P, int l, int bh, int q, bool sample, LAS unsigned char* lds) {
    constexpr int MT = C / 16, KS = C / 32, NB3 = C / 32, BUF = 62464;
    const int tid = tid_l(), lane = tid & 63, wave = tid >> 6, m = lane & 15, kq = lane >> 4, b = bh >> 2, h = bh & 3;
    const bool active = wave < 2; const int ct = q * 2 + (wave & 1), vcol = ct * 16 + m;
    bf16_t* mixcat = (bf16_t*)(P.ws + WS_ACT);
    f32x4 S[8];
    if (sample && active) { const float* sd = P.in[5] + ((size_t)(l * 8 + b) * 4 + h) * 16384;
#pragma unroll
        for (int kt = 0; kt < 8; ++kt)
#pragma unroll
            for (int r = 0; r < 4; ++r) S[kt][r] = sd[(16 * kt + kq * 4 + r) * 128 + vcol];
    } else {
#pragma unroll
        for (int kt = 0; kt < 8; ++kt) S[kt] = (f32x4){0.f, 0.f, 0.f, 0.f};
    }
    const int nch = sample ? 1 : 32;
    u32x4 pfW[NB3], pfQ[NB3], pfA, pfK[2]; float glp;
#define SCAN_ISSUE(ci_) do { const int slot_ = sample ? 1024 + bh : bh * 32 + (ci_); \
        const bf16_t* gWC = (const bf16_t*)(P.ws + WS_WC) + (size_t)slot_ * 8192; const bf16_t* gQG = (const bf16_t*)(P.ws + WS_QG) + (size_t)slot_ * 8192; \
        const bf16_t* gKG = (const bf16_t*)(P.ws + WS_KGT) + (size_t)slot_ * 8192; \
        const bf16_t* gAT = (const bf16_t*)(P.ws + WS_ATT) + (size_t)slot_ * 4096; \
        _Pragma("unroll") for (int i_ = 0; i_ < NB3; ++i_) { const int idx_ = tid + 512 * i_, r_ = idx_ >> 4, c8_ = (idx_ & 15) * 8; \
            pfW[i_] = *(const u32x4*)(gWC + r_ * 128 + c8_); pfQ[i_] = *(const u32x4*)(gQG + r_ * 128 + c8_); } \
        if (tid < C * 8) pfA = *(const u32x4*)(gAT + (tid >> 3) * 64 + (tid & 7) * 8); \
        _Pragma("unroll") for (int i_ = 0; i_ < 2; ++i_) { const int idx_ = tid + 512 * i_; pfK[i_] = *(const u32x4*)(gKG + (idx_ >> 3) * 64 + (idx_ & 7) * 8); } \
        glp = ((const float*)(P.ws + WS_GL))[slot_]; } while (0)
#define U_ISSUE(ci_, dst_) do { if (active) { const bf16_t* gUC_ = (const bf16_t*)(P.ws + WS_UC) + (size_t)(sample ? 1024 + bh : bh * 32 + (ci_)) * 8192; \
        _Pragma("unroll") for (int mt_ = 0; mt_ < MT; ++mt_) dst_[mt_] = *(const u32x2*)(gUC_ + ((ct * 4 + mt_) * 64 + lane) * 4); } } while (0)
#define SCAN_STORE(par_) do { LAS bf16_t* W_ = (LAS bf16_t*)(lds + (par_) * BUF); LAS bf16_t* Q_ = (LAS bf16_t*)(lds + (par_) * BUF + 17408); \
        LAS bf16_t* A_ = (LAS bf16_t*)(lds + (par_) * BUF + 34816); LAS bf16_t* K_ = (LAS bf16_t*)(lds + (par_) * BUF + 44032); \
        _Pragma("unroll") for (int i_ = 0; i_ < NB3; ++i_) { const int idx_ = tid + 512 * i_, r_ = idx_ >> 4, c8_ = (idx_ & 15) * 8; \
            *(LAS u32x4*)(W_ + r_ * 136 + c8_) = pfW[i_]; *(LAS u32x4*)(Q_ + r_ * 136 + c8_) = pfQ[i_]; } \
        if (tid < C * 8) *(LAS u32x4*)(A_ + (tid >> 3) * 72 + (tid & 7) * 8) = pfA; \
        _Pragma("unroll") for (int i_ = 0; i_ < 2; ++i_) { const int idx_ = tid + 512 * i_; *(LAS u32x4*)(K_ + (idx_ >> 3) * 72 + (idx_ & 7) * 8) = pfK[i_]; } } while (0)
    u32x2 uc[MT], un[MT]; float gl, gln = 0.f;
#pragma unroll
    for (int mt = 0; mt < MT; ++mt) { uc[mt] = (u32x2){0u, 0u}; un[mt] = (u32x2){0u, 0u}; }
    SCAN_ISSUE(0);
    U_ISSUE(0, uc);
    SCAN_STORE(0);
    gl = glp;
    if (nch > 1) SCAN_ISSUE(1);
    __syncthreads();
    for (int ci = 0; ci < nch; ++ci) {
        const int par = ci & 1, row0 = sample ? TP + b * 32 : b * 2048 + ci * 64;
        if (ci + 1 < nch) {
            U_ISSUE(ci + 1, un);
            SCAN_STORE(par ^ 1);
            gln = glp;
            if (ci + 2 < nch) SCAN_ISSUE(ci + 2);
        }
        if (active) {
            const LAS bf16_t* WCs = (const LAS bf16_t*)(lds + par * BUF); const LAS bf16_t* QGs = (const LAS bf16_t*)(lds + par * BUF + 17408);
            const LAS bf16_t* ATs = (const LAS bf16_t*)(lds + par * BUF + 34816); const LAS bf16_t* KGs = (const LAS bf16_t*)(lds + par * BUF + 44032);
            bf16x8 Sb[4];
#pragma unroll
            for (int s = 0; s < 4; ++s) Sb[s] = packB(S[2 * s], S[2 * s + 1]);
            f32x4 vn[MT], oa[MT];
#pragma unroll
            for (int mt = 0; mt < MT; ++mt) { oa[mt] = (f32x4){0.f, 0.f, 0.f, 0.f};
                vn[mt] = (f32x4){-bflo(uc[mt].x), -bfhi(uc[mt].x), -bflo(uc[mt].y), -bfhi(uc[mt].y)}; }
            bf16x8 f0[4], f1[4];
#define SCAN_SB() __builtin_amdgcn_sched_barrier(0)
#define LD_ROWS(dst, X, ld, s_) _Pragma("unroll") for (int mt = 0; mt < MT; ++mt) dst[mt] = ldA(X, ld, 16 * mt + m, (s_), kq);
#define LD_KT(dst, s_, k0_) _Pragma("unroll") for (int kt = 0; kt < 4; ++kt) dst[kt] = ldA(KGs, 72, 16 * ((k0_) + kt) + m, (s_), kq);
#define MM_ROWS(acc, src, bop) _Pragma("unroll") for (int mt = 0; mt < MT; ++mt) acc[mt] = MFMA16(src[mt], (bop), acc[mt]);
#define MM_KT(src, bop, k0_) _Pragma("unroll") for (int kt = 0; kt < 4; ++kt) S[(k0_) + kt] = MFMA16(src[kt], (bop), S[(k0_) + kt]);
            LD_ROWS(f0, WCs, 136, 0); LD_ROWS(f1, WCs, 136, 1); SCAN_SB();
            MM_ROWS(vn, f0, Sb[0]); LD_ROWS(f0, WCs, 136, 2); SCAN_SB();
            MM_ROWS(vn, f1, Sb[1]); LD_ROWS(f1, WCs, 136, 3); SCAN_SB();
            MM_ROWS(vn, f0, Sb[2]); LD_ROWS(f0, QGs, 136, 0); SCAN_SB();
            MM_ROWS(vn, f1, Sb[3]); LD_ROWS(f1, QGs, 136, 1); SCAN_SB();
            MM_ROWS(oa, f0, Sb[0]); LD_ROWS(f0, QGs, 136, 2); SCAN_SB();
            MM_ROWS(oa, f1, Sb[1]); LD_ROWS(f1, QGs, 136, 3); SCAN_SB();
            MM_ROWS(oa, f0, Sb[2]); LD_ROWS(f0, ATs, 72, 0); SCAN_SB();
            MM_ROWS(oa, f1, Sb[3]);
#pragma unroll
            for (int mt = 0; mt < MT; ++mt)
#pragma unroll
                for (int r = 0; r < 4; ++r) vn[mt][r] = -vn[mt][r];
            bf16x8 Vb[KS];
#pragma unroll
            for (int s = 0; s < KS; ++s) Vb[s] = packB(vn[2 * s], vn[2 * s + 1]);
#pragma unroll
            for (int kt = 0; kt < 8; ++kt) S[kt] = S[kt] * gl;
            if (KS == 2) {
                LD_ROWS(f1, ATs, 72, KS - 1); SCAN_SB();
                MM_ROWS(oa, f0, Vb[0]); LD_KT(f0, 0, 0); SCAN_SB();
                MM_ROWS(oa, f1, Vb[KS - 1]); LD_KT(f1, 0, 4); SCAN_SB();
                MM_KT(f0, Vb[0], 0); LD_KT(f0, KS - 1, 0); SCAN_SB();
                MM_KT(f1, Vb[0], 4); LD_KT(f1, KS - 1, 4); SCAN_SB();
                MM_KT(f0, Vb[KS - 1], 0); SCAN_SB();
                MM_KT(f1, Vb[KS - 1], 4);
            } else {
                LD_KT(f1, 0, 0); SCAN_SB();
                MM_ROWS(oa, f0, Vb[0]); LD_KT(f0, 0, 4); SCAN_SB();
                MM_KT(f1, Vb[0], 0); SCAN_SB();
                MM_KT(f0, Vb[0], 4);
            }
            { bf16_t* op = mixcat + (size_t)(row0 + kq * 4) * 1024 + 512 + h * 128 + vcol;
#pragma unroll
              for (int mt = 0; mt < MT; ++mt) {
#pragma unroll
                for (int r = 0; r < 4; ++r) { *op = f2bf(oa[mt][r]); op += 1024; asm volatile("" : "+v"(op)); }
                op += 12 * 1024; asm volatile("" : "+v"(op)); } }
#undef LD_ROWS
#undef LD_KT
#undef MM_KT
#undef MM_ROWS
#undef SCAN_SB
        }
        __syncthreads();
#pragma unroll
        for (int mt = 0; mt < MT; ++mt) uc[mt] = un[mt];
        gl = gln;
    }
#undef SCAN_ISSUE
#undef SCAN_STORE
#undef U_ISSUE
    if (active) { float* od = P.out + (sample ? O_SDELTA : O_PDELTA) + ((size_t)(l * 8 + b) * 4 + h) * 16384;
#pragma unroll
        for (int kt = 0; kt < 8; ++kt)
#pragma unroll
            for (int r = 0; r < 4; ++r) od[(16 * kt + kq * 4 + r) * 128 + vcol] = S[kt][r]; }
    __syncthreads();
}
__device__ __forceinline__ void phase_gnorm(const Params& P, int l) {
    const int tid = tid_l(), lane = tid & 63, wave = tid >> 6;
    bf16_t* mixcat = (bf16_t*)(P.ws + WS_ACT); const bf16_t* p = (const bf16_t*)(P.ws + WS_A);
    const float* gn = P.in[17] + l * 128 + (lane & 15) * 8;
    const f32x4 g0 = *(const f32x4*)gn, g1 = *(const f32x4*)(gn + 4);
    const int rstride = gridDim.x * 8; int r = bid_l() * 8 + wave;
    u32x4 ov, zv;
    if (r < TT) { ov = *(const u32x4*)(mixcat + (size_t)r * 1024 + 512 + lane * 8); zv = *(const u32x4*)(p + (size_t)r * 3072 + 2560 + lane * 8); }
    for (; r < TT; r += rstride) {
        u32x4 on, zn; const int rn_ = r + rstride;
        if (rn_ < TT) { on = *(const u32x4*)(mixcat + (size_t)rn_ * 1024 + 512 + lane * 8); zn = *(const u32x4*)(p + (size_t)rn_ * 3072 + 2560 + lane * 8); }
        float o[8], z[8]; float ss = 0.f;
#pragma unroll
        for (int e = 0; e < 4; ++e) { o[2 * e] = bflo(ov[e]); o[2 * e + 1] = bfhi(ov[e]); z[2 * e] = bflo(zv[e]); z[2 * e + 1] = bfhi(zv[e]); }
#pragma unroll
        for (int e = 0; e < 8; ++e) ss += o[e] * o[e];
        ss += __shfl_xor(ss, 1); ss += __shfl_xor(ss, 2); ss += __shfl_xor(ss, 4); ss += __shfl_xor(ss, 8);
        const float rstd = rsqrtf(ss * (1.f / 128.f) + 1e-6f);
        u32x4 w; w.x = pk2(o[0] * rstd * g0[0] * z[0], o[1] * rstd * g0[1] * z[1]); w.y = pk2(o[2] * rstd * g0[2] * z[2], o[3] * rstd * g0[3] * z[3]);
        w.z = pk2(o[4] * rstd * g1[0] * z[4], o[5] * rstd * g1[1] * z[5]); w.w = pk2(o[6] * rstd * g1[2] * z[6], o[7] * rstd * g1[3] * z[7]);
        *(u32x4*)(mixcat + (size_t)r * 1024 + 512 + lane * 8) = w;
        ov = on; zv = zn;
    }
}

template <int PC> __device__ __forceinline__ void sgu_item(const Params& P, int l, int b, int row0, bool sample, int g0, int g1, LAS unsigned char* lds) {
    constexpr int LDV = PC + 8, KS = PC / 32;
#define SGU_SWZ(c_) ((((c_) >> 3) & (PC / 8 - 1)) << 3)
    const int tid = tid_l(), lane = tid & 63, wave = tid >> 6, m = lane & 15, kq = lane >> 4;
    LAS bf16_t* vT = (LAS bf16_t*)lds;
    LAS float* rstd = (LAS float*)(lds + 128 * LDV * 2);
    const bf16_t* p = (const bf16_t*)(P.ws + WS_A); bf16_t* mixcat = (bf16_t*)(P.ws + WS_ACT);
    { u32x4 rw[PC / 8];
#pragma unroll
        for (int i = 0; i < PC / 8; ++i) rw[i] = *(const u32x4*)(p + (size_t)(row0 + wave + 8 * i) * 3072 + 512 + lane * 8);
#pragma unroll
        for (int i = 0; i < PC / 8; ++i) { float ss = 0.f;
#pragma unroll
            for (int e = 0; e < 4; ++e) { const float a = bflo(rw[i][e]), c = bfhi(rw[i][e]); ss += a * a + c * c; }
            ss = wave_sum(ss); if (lane == 0) rstd[wave + 8 * i] = rsqrtf(ss * (1.f / 512.f) + 1e-6f); } }
    __syncthreads();
    for (int g = g0; g < g1; ++g) {
        const float* gam = P.in[11] + l * 512 + g * 128;
        constexpr int NBV = PC / 32;
        u32x4 rv[NBV];
#pragma unroll
        for (int i = 0; i < NBV; ++i) { const int idx = tid + 512 * i, q = idx >> 4, c8 = (idx & 15) * 8; rv[i] = *(const u32x4*)(p + (size_t)(row0 + q) * 3072 + 512 + g * 128 + c8); }
#pragma unroll
        for (int i = 0; i < NBV; ++i) { const int idx = tid + 512 * i, q = idx >> 4, c8 = (idx & 15) * 8; const u32x4 raw = rv[i]; const float rs = rstd[q];
#pragma unroll
            for (int e = 0; e < 8; ++e) { const float x = (e & 1) ? bfhi(raw[e >> 1]) : bflo(raw[e >> 1]); const float vn = x * rs * gam[c8 + e];
                vT[(c8 + e) * LDV + (q ^ SGU_SWZ(c8))] = f2bf(vn);
                if (sample) P.out[O_SGUV + ((size_t)(l * 8 + b) * 32 + q) * 512 + g * 128 + c8 + e] = vn; } }
        __syncthreads();
        int pt, ct0, nks;
        if (PC == 128) { pt = wave; ct0 = 0; nks = (pt < 4) ? 2 : 4; } else { pt = wave & 1; ct0 = (wave >> 1) * 2; nks = 1; }
        const int prow = 16 * pt + m; const float* wrow = P.in[12] + ((size_t)(l * 4 + g) * 128 + prow) * 128;
        bf16x8 Wf[KS];
#pragma unroll
        for (int s = 0; s < KS; ++s) { if (s < nks) { const f32x4 a = *(const f32x4*)(wrow + 32 * s + kq * 8), c = *(const f32x4*)(wrow + 32 * s + kq * 8 + 4);
                Wf[s] = mk8(pk2(a[0], a[1]), pk2(a[2], a[3]), pk2(c[0], c[1]), pk2(c[2], c[3])); } else Wf[s] = mk8(0u, 0u, 0u, 0u); }
        const float bias = P.in[13][(l * 4 + g) * 128 + prow];
        const size_t row = (size_t)(row0 + prow);
        constexpr int NCT = PC == 128 ? 8 : 2;
        u32x2 urv[NCT];
#pragma unroll
        for (int i = 0; i < NCT; ++i) urv[i] = *(const u32x2*)(p + row * 3072 + g * 128 + 16 * (ct0 + i) + kq * 4);
#pragma unroll
        for (int i = 0; i < NCT; ++i) { const int ct = ct0 + i; f32x4 acc = {0.f, 0.f, 0.f, 0.f};
#pragma unroll
            for (int s = 0; s < KS; ++s) if (s < nks) acc = MFMA16(*(const LAS bf16x8*)(vT + (16 * ct + m) * LDV + ((32 * s + kq * 8) ^ SGU_SWZ(16 * ct + m))), Wf[s], acc);
            const int ch = g * 128 + 16 * ct + kq * 4;
            const u32x2 ur = urv[i];
            u32x2 w; w.x = pk2(bflo(ur.x) * (acc[0] + bias), bfhi(ur.x) * (acc[1] + bias)); w.y = pk2(bflo(ur.y) * (acc[2] + bias), bfhi(ur.y) * (acc[3] + bias));
            *(u32x2*)(mixcat + row * 1024 + ch) = w; }
        __syncthreads();
    }
}
__device__ __forceinline__ void phase_scan_sgu(const Params& P, int l, LAS unsigned char* lds) {
    const int bid = bid_l(); const bool isScan = bid < 128; const int j = bid - 128;
    if (isScan) scan_job<64>(P, l, (bid & 7) + 8 * (bid >> 5), (bid >> 3) & 3, false, lds);
    else scan_job<32>(P, l, (j & 7) + 8 * (j >> 5), (j >> 3) & 3, true, lds);
    const int nq = isScan ? 1 : 3;
    for (int k = 0; k < nq; ++k) { const int qi = isScan ? 384 + bid : j + 128 * k; const int it = qi >> 2, g = qi & 3, b = it >> 4, n = it & 15;
        sgu_item<128>(P, l, b, b * 2048 + n * 128, false, g, g + 1, lds); }
    if (!isScan && j < 8) sgu_item<32>(P, l, j, TP + j * 32, true, 0, 4, lds);
}

__device__ __forceinline__ void phase_final(const Params& P) {
    const int tid = tid_l(), lane = tid & 63, wave = tid >> 6;
    for (int r = bid_l() * 8 + wave; r < TT; r += gridDim.x * 8) { float* xr = P.out + (size_t)r * 1024;
        f32x4 v[4]; float ss = 0.f;
#pragma unroll
        for (int i = 0; i < 4; ++i) { v[i] = *(const f32x4*)(xr + lane * 4 + 256 * i); ss += v[i][0] * v[i][0] + v[i][1] * v[i][1] + v[i][2] * v[i][2] + v[i][3] * v[i][3]; }
        ss = wave_sum(ss); const float rstd = rsqrtf(ss * (1.f / 1024.f) + 1e-6f);
#pragma unroll
        for (int i = 0; i < 4; ++i) { const f32x4 g4 = *(const f32x4*)(P.in[21] + lane * 4 + 256 * i); *(f32x4*)(xr + lane * 4 + 256 * i) = v[i] * rstd * g4; } }
}

#define XB_TMO      128
#define XB_XCNT(j)  (256  + 64 * (j))
#define XB_XSUB(j)  (1280 + 64 * (j))
#define XB_XGEN(j)  (2304 + 64 * (j))
#define XB_TOP      3328
#define XB_TOPGEN   3392
#define XCD_BAR_WORDS 3456
#define XB_SPIN_CAP (1u << 18)

__device__ __forceinline__ unsigned xb_ld(unsigned* p)              { return __hip_atomic_load(p, __ATOMIC_RELAXED, __HIP_MEMORY_SCOPE_AGENT); }
__device__ __forceinline__ unsigned xb_add(unsigned* p, unsigned v) { return __hip_atomic_fetch_add(p, v, __ATOMIC_RELAXED, __HIP_MEMORY_SCOPE_AGENT); }
__device__ __forceinline__ unsigned xb_xcc_id() { return (unsigned)__builtin_amdgcn_s_getreg((3 << 11) | 20) & 0xFu; }
#define XB_SPIN(cond, bar) do { unsigned _sp = 0; while (cond) { __builtin_amdgcn_s_sleep(1); \
    if ((++_sp & 255u) == 0u) { if (xb_ld(&(bar)[XB_TMO])) break; if (_sp > XB_SPIN_CAP) { atomicAdd(&(bar)[XB_TMO], 1u); break; } } } } while (0)

struct XcdBarrier {
    unsigned* bar; unsigned x;
    volatile LAS unsigned* st;
};

__device__ __forceinline__ XcdBarrier xcd_barrier_post(unsigned* bar, volatile LAS unsigned* st) {
    XcdBarrier b; b.bar = bar; b.x = xb_xcc_id(); b.st = st;
    if (threadIdx.x == 0) (void)xb_add(&bar[XB_XCNT(b.x)], 1u);
    return b;
}
__device__ __forceinline__ void xcd_barrier_complete(unsigned* bar, unsigned x, unsigned& nloc, unsigned& nx) {
    const unsigned G = gridDim.x * gridDim.y * gridDim.z;
    unsigned sum, cnt, mine, sp = 0u;
    for (;;) {
        sum = 0u; cnt = 0u; mine = 0u;
#pragma unroll
        for (unsigned j = 0; j < 16; ++j) { const unsigned c = xb_ld(&bar[XB_XCNT(j)]); sum += c; cnt += (c > 0u) ? 1u : 0u; mine = (j == x) ? c : mine; }
        if (sum == G) break;
        __builtin_amdgcn_s_sleep(1);
        if ((++sp & 255u) == 0u) { if (xb_ld(&bar[XB_TMO])) break; if (sp > XB_SPIN_CAP) { atomicAdd(&bar[XB_TMO], 1u); break; } }
    }
    nloc = mine > 0u ? mine : 1u; nx = cnt > 0u ? cnt : 1u;
}

__device__ __forceinline__ void xcd_barrier(const XcdBarrier& b) {
    asm volatile("s_waitcnt vmcnt(0)" ::: "memory");
    __syncthreads();
    if (threadIdx.x == 0) {
        unsigned* bar = b.bar;
        __builtin_amdgcn_s_waitcnt(0);
        unsigned nloc = b.st[0], nx = b.st[1];
        if (nloc == 0u) { xcd_barrier_complete(bar, b.x, nloc, nx); b.st[0] = nloc; b.st[1] = nx; }
        const unsigned old = xb_add(&bar[XB_XSUB(b.x)], 1u);
        const unsigned gen = old / nloc;
        if (old + 1u == (gen + 1u) * nloc) {
            __builtin_amdgcn_fence(__ATOMIC_RELEASE, "agent");
            asm volatile("s_waitcnt vmcnt(0)" ::: "memory");
            const unsigned og = xb_add(&bar[XB_TOP], 1u);
            const unsigned tg = og / nx;
            if (og + 1u == (tg + 1u) * nx) xb_add(&bar[XB_TOPGEN], 1u);
            else XB_SPIN(xb_ld(&bar[XB_TOPGEN]) == tg, bar);
            __builtin_amdgcn_fence(__ATOMIC_ACQUIRE, "agent");
            xb_add(&bar[XB_XGEN(b.x)], 1u);
            asm volatile("s_waitcnt vmcnt(0)" ::: "memory");
        } else {
            XB_SPIN(xb_ld(&bar[XB_TOPGEN]) == gen, bar);
            __builtin_amdgcn_fence(__ATOMIC_ACQUIRE, "agent");
            asm volatile("s_waitcnt vmcnt(0)" ::: "memory");
        }
    }
    __syncthreads();
}

constexpr int N_PHASES = 20;
__global__ void __launch_bounds__(512, 2) mega(Params P) {
    extern __shared__ __attribute__((aligned(16))) unsigned char lds_raw[];
    LAS unsigned char* lds = (LAS unsigned char*)lds_raw;
    cg::grid_group grid = cg::this_grid();
    unsigned* barw = (unsigned*)(P.ws + WS_BAR);
    volatile LAS unsigned* bst = (volatile LAS unsigned*)(lds + 155648);
    if (threadIdx.x < 2) bst[threadIdx.x] = 0u;
    __syncthreads();
    XcdBarrier bar = xcd_barrier_post(barw, bst);
    if (P.ph_hi > 1000) grid.sync();
    int ph = 0;
#ifndef PROBE_KIND
#define PROBE_KIND -1
#endif
#define PHASE(kind, ...) do { if (ph >= P.ph_lo && ph < P.ph_hi) { int nrep_ = ((kind) == PROBE_KIND) ? 2 : 1; asm volatile("" : "+s"(nrep_)); \
        for (int rep_ = 0; rep_ < nrep_; ++rep_) { __VA_ARGS__; if (rep_ + 1 < nrep_) __syncthreads(); } \
        if (ph + 1 < P.ph_hi) xcd_barrier(bar); } ++ph; } while (0)
    PHASE(0, phase0(P, lds));
#pragma unroll 1
    for (int l = 0; l < 2; ++l) {
        const unsigned char* wl = P.ws + (size_t)l * W_LAYER;
        const float* modl = (const float*)(P.ws + WS_MOD) + (size_t)l * 16 * 6144;
        PHASE(1, phase_h<true>(P, l, lds));
        PHASE(2, { EpiP e; e.O = (bf16_t*)(P.ws + WS_A); run_gemm<true>(lds, (const bf16_t*)(P.ws + WS_B), (const bf16_t*)(wl + W_IN), 3072, 1024, e);
                small_gemm<64, 64, 4>(lds, (const bf16_t*)(P.ws + WS_B), (const bf16_t*)(wl + W_IN), 3072, 1024, e); });
        PHASE(3, phase_b1(P, l, lds));
        PHASE(4, phase_scan_sgu(P, l, lds));
        PHASE(10, phase_gnorm(P, l));
        PHASE(5, { EpiRes e; e.base_p = l == 0 ? P.in[0] : P.out; e.base_s = l == 0 ? P.in[1] : P.out + O_YS; e.out = P.out; e.gate = modl + 2048;
                run_gemm<false>(lds, (const bf16_t*)(P.ws + WS_ACT), (const bf16_t*)(wl + W_OUT), 1024, 1024, e);
                small_gemm<32, 32, 4>(lds, (const bf16_t*)(P.ws + WS_ACT), (const bf16_t*)(wl + W_OUT), 1024, 1024, e); });
        PHASE(6, phase_h<false>(P, l, lds));
        PHASE(7, { EpiH e; e.O = (bf16_t*)(P.ws + WS_A); run_gemm<true>(lds, (const bf16_t*)(P.ws + WS_B), (const bf16_t*)(wl + W_UP), 4096, 1024, e);
                small_gemm<64, 64, 4>(lds, (const bf16_t*)(P.ws + WS_B), (const bf16_t*)(wl + W_UP), 4096, 1024, e); });
        PHASE(8, { EpiRes e; e.base_p = P.out; e.base_s = P.out + O_YS; e.out = P.out; e.gate = modl + 5120;
                run_gemm<false>(lds, (const bf16_t*)(P.ws + WS_A), (const bf16_t*)(wl + W_DOWN), 1024, 4096, e);
                small_gemm<32, 32, 8>(lds, (const bf16_t*)(P.ws + WS_A), (const bf16_t*)(wl + W_DOWN), 1024, 4096, e); });
    }
    PHASE(9, phase_final(P));
#undef PHASE
}

#ifndef MK_PER_PHASE
#define MK_PER_PHASE 0
#endif
extern "C" void kernel_launch(void* const* d_in, const int* in_sizes, int n_in, void* d_out, int out_size, void* d_ws, size_t ws_size, hipStream_t stream) {
    static int grid = 0;
    if (grid == 0) {
        if (n_in != 22 || (size_t)out_size != O_END || ws_size < WS_END) { fprintf(stderr, "kernel_launch: unexpected shapes: n_in %d out %d ws %zu (need %zu)\n", n_in, out_size, ws_size, (size_t)WS_END); grid = -1; return; }
        int dev = 0, cus = 0, per_cu = 0;
        if (hipGetDevice(&dev) != hipSuccess || hipDeviceGetAttribute(&cus, hipDeviceAttributeMultiprocessorCount, dev) != hipSuccess) { grid = -1; return; }
        if (hipFuncSetAttribute((const void*)mega, hipFuncAttributeMaxDynamicSharedMemorySize, LDS_BYTES) != hipSuccess) { fprintf(stderr, "kernel_launch: hipFuncSetAttribute failed\n"); grid = -1; return; }
        if (hipOccupancyMaxActiveBlocksPerMultiprocessor(&per_cu, (const void*)mega, 512, LDS_BYTES) != hipSuccess || per_cu < 1) { fprintf(stderr, "kernel_launch: occupancy query says %d\n", per_cu); (void)hipGetLastError(); grid = -1; return; }
        if (cus < 256) { fprintf(stderr, "kernel_launch: needs 256 CUs, device has %d\n", cus); grid = -1; return; }
        grid = 256;
    }
    if (grid < 0) return;
    Params p{};
    for (int i = 0; i < 22; ++i) p.in[i] = (const float*)d_in[i];
    p.out = (float*)d_out; p.ws = (unsigned char*)d_ws;
#if MK_PER_PHASE
    for (int ph = 0; ph < N_PHASES; ++ph) { p.ph_lo = ph; p.ph_hi = ph + 1; hipLaunchKernelGGL(mega, dim3(grid), dim3(512), LDS_BYTES, stream, p); }
#else
    p.ph_lo = 0; p.ph_hi = N_PHASES;
    if (hipMemsetAsync((char*)d_ws + WS_BAR, 0, 3456 * 4, stream) != hipSuccess) { fprintf(stderr, "kernel_launch: memset of the barrier words failed\n"); return; }
    void* args[] = {&p};
    const hipError_t e = hipLaunchCooperativeKernel((const void*)mega, dim3(grid), dim3(512), args, LDS_BYTES, stream);
    if (e != hipSuccess) fprintf(stderr, "kernel_launch: cooperative launch failed: %s (grid %d)\n", hipGetErrorString(e), grid);
#endif
}
```

```cpp
#include <hip/hip_runtime.h>
#include <hip/hip_cooperative_groups.h>
#include <cstdio>
#include <cstdint>
namespace cg = cooperative_groups;
namespace pg8 {
#define PG8_LAS __attribute__((address_space(3)))
typedef unsigned short bf16_t;
typedef short bf16x8 __attribute__((ext_vector_type(8)));
typedef float f32x4 __attribute__((ext_vector_type(4)));
typedef unsigned u32x4 __attribute__((ext_vector_type(4)));
constexpr int BM = 256, BK = 64, HALF = 128, HTB = HALF * BK * 2  , STAGE_BYTES = 8 * HTB, NXCD = 8, WGM = 8;

__host__ __device__ __forceinline__ int lds_byte(int r, int c) { const int st = (r >> 4) * 2 + (c >> 5), rr = r & 15, cc = c & 31, ob = rr * 64 + cc * 2; return st * 1024 + (ob ^ (((ob >> 9) & 1) << 5)); }
__host__ __device__ __forceinline__ void stage_rc(int b, int& R, int& C) { const int st = b / 1024, sb = b % 1024, swz = sb ^ (((sb >> 9) & 1) << 5); R = (st >> 1) * 16 + swz / 64; C = (st & 1) * 32 + (swz % 64) / 2; }
__host__ __device__ __forceinline__ int perm32(int rho) { const int n = rho >> 4, i = rho & 15; return 8 * (i >> 2) + 4 * n + (i & 3); }

struct Unit { int pm, pn; };
struct Gemm { const bf16_t* A; const bf16_t* Bt; int M, N, K; };

struct StaticOrder {
    int nM, nN, nwg, G, c;
    __host__ __device__ void init(int M, int N, int G_, int c_) { nM = M / BM; nN = N / BM; nwg = nM * nN; G = G_; c = c_; }
    __host__ __device__ bool next(int i, Unit& u) const {
        const long L = (long)i * G + c; if (L >= nwg) return false;
        int wgid = (int)L; { const int q = nwg / NXCD, r = nwg % NXCD, xcd = wgid % NXCD, off = wgid / NXCD; wgid = (xcd < r ? xcd * (q + 1) : r * (q + 1) + (xcd - r) * q) + off; }
        const int nig = WGM * nN, gid = wgid / nig, fm = gid * WGM, gsz = (nM - fm) < WGM ? (nM - fm) : WGM;
        u.pm = fm + ((wgid % nig) % gsz); u.pn = (wgid % nig) / gsz; return true;
    }
    __device__ __forceinline__ void a_ready(const Unit&) const {}
    __device__ __forceinline__ void done(const Unit&) const {}
};
__device__ __forceinline__ unsigned cvt_pk_bf16(float lo, float hi) { unsigned r; asm volatile("v_cvt_pk_bf16_f32 %0, %1, %2" : "=v"(r) : "v"(lo), "v"(hi)); return r; }
typedef float f32x2 __attribute__((ext_vector_type(2)));
template <class Epi, class Sched, bool ALIGN_EPI = false, bool SP2 = false>
__device__ __forceinline__ void gemm_phase(PG8_LAS unsigned char* lds, const Gemm g, const Sched& S, const Epi& E) {
    int tid_ = threadIdx.x; asm volatile("" : "+v"(tid_));
    const int tid = tid_, wid = __builtin_amdgcn_readfirstlane(tid >> 6), lane = tid & 63, wr = wid >> 2, wc = wid & 3, fr = lane & 15, fq = lane >> 4;
    const int K = g.K, nt = K / BK;
    unsigned voffA[2], voffB[2];
#pragma unroll
    for (int i = 0; i < 2; ++i) { int R, C; stage_rc(tid * 16 + i * 8192, R, C); const int Rb = Epi::PERM ? ((R & ~31) + perm32(R & 31)) : R;
        voffA[i] = (unsigned)(R * K + C) * 2u; voffB[i] = (unsigned)(Rb * K + C) * 2u; }
    const size_t kstep = (size_t)(BK * 2);
    const size_t hstep = (size_t)HALF * K * 2;
    const size_t tstep = 2 * hstep;
    const unsigned ldsw = (unsigned)wid * 1024u;
    const int aoff = lds_byte(wr * 64 + fr, fq * 8), boff = lds_byte(wc * 32 + fr, fq * 8);
#define PG8_SA(b, h) (((b) * 2 + (h)) * HTB)
#define PG8_SB(b, h) ((4 + (b) * 2 + (h)) * HTB)
#define PG8_STAGE(bufoff, gbase, voff) do { _Pragma("unroll") for (int _i = 0; _i < 2; ++_i) \
        __builtin_amdgcn_global_load_lds((const unsigned*)((const char*)(gbase) + (voff)[_i]), (PG8_LAS unsigned*)(lds + (bufoff) + ldsw + _i * 8192), 16, 0, 0); } while (0)
#define PG8_LDA(dst, b, h) do { _Pragma("unroll") for (int m = 0; m < 4; ++m) _Pragma("unroll") for (int k = 0; k < 2; ++k) dst[m][k] = *(const PG8_LAS bf16x8*)(lds + PG8_SA(b, h) + aoff + m * 2048 + k * 1024); } while (0)
#define PG8_LDB(dst, b, h) do { _Pragma("unroll") for (int n = 0; n < 2; ++n) _Pragma("unroll") for (int k = 0; k < 2; ++k) dst[n][k] = *(const PG8_LAS bf16x8*)(lds + PG8_SB(b, h) + boff + n * 2048 + k * 1024); } while (0)
#define PG8_MMA(ai, bj, At, Bt) do { __builtin_amdgcn_s_setprio(1); _Pragma("unroll") for (int m = 0; m < 4; ++m) _Pragma("unroll") for (int n = 0; n < 2; ++n) _Pragma("unroll") for (int k = 0; k < 2; ++k) \
        acc[ai][bj][m][n] = __builtin_amdgcn_mfma_f32_16x16x32_bf16(Bt[n][k], At[m][k], acc[ai][bj][m][n], 0, 0, 0); __builtin_amdgcn_s_setprio(0); } while (0)
#define PG8_WAIT_V(n) asm volatile("s_waitcnt vmcnt(" #n ")" ::: "memory")
#define PG8_WAIT_L(n) asm volatile("s_waitcnt lgkmcnt(" #n ")" ::: "memory")
#define PG8_BAR __builtin_amdgcn_s_barrier()
#define PG8_SCHED __builtin_amdgcn_sched_barrier(0)
    Unit cur, nxt; int ui = 0;
    if (!S.next(0, cur)) return;
    f32x4 acc[2][2][4][2];
#pragma unroll
    for (int a = 0; a < 2; ++a)
#pragma unroll
        for (int b = 0; b < 2; ++b)
#pragma unroll
            for (int m = 0; m < 4; ++m)
#pragma unroll
                for (int n = 0; n < 2; ++n) acc[a][b][m][n] = (f32x4){0.f, 0.f, 0.f, 0.f};
    bf16x8 At[4][2], B0[2][2], B1[2][2];
    const char* cA = (const char*)g.A + (size_t)cur.pm * tstep; const char* cB = (const char*)g.Bt + (size_t)cur.pn * tstep;
    S.a_ready(cur);
    if constexpr (SP2) {
        PG8_STAGE(PG8_SB(0, 0), cB, voffB); PG8_STAGE(PG8_SB(0, 1), cB + hstep, voffB); PG8_STAGE(PG8_SA(0, 0), cA, voffA); PG8_STAGE(PG8_SA(0, 1), cA + hstep, voffA);
        if (wr == 1) PG8_BAR;
        PG8_WAIT_V(2); PG8_BAR;
        PG8_STAGE(PG8_SB(1, 0), cB + kstep, voffB); PG8_STAGE(PG8_SA(1, 0), cA + kstep, voffA); PG8_STAGE(PG8_SB(1, 1), cB + hstep + kstep, voffB);
        PG8_WAIT_V(6); PG8_BAR;
    } else {
        PG8_STAGE(PG8_SB(0, 0), cB, voffB); PG8_STAGE(PG8_SA(0, 0), cA, voffA); PG8_STAGE(PG8_SB(0, 1), cB + hstep, voffB); PG8_STAGE(PG8_SA(0, 1), cA + hstep, voffA);
        if (wr == 1) PG8_BAR;
        PG8_WAIT_V(4); PG8_BAR;
        PG8_STAGE(PG8_SB(1, 0), cB + kstep, voffB); PG8_STAGE(PG8_SA(1, 0), cA + kstep, voffA); PG8_STAGE(PG8_SB(1, 1), cB + hstep + kstep, voffB);
        PG8_WAIT_V(6); PG8_BAR;
    }
    for (;;) {
        const bool has_next = S.next(ui + 1, nxt);
        const char* nA = has_next ? (const char*)g.A + (size_t)nxt.pm * tstep : cA; const char* nB = has_next ? (const char*)g.Bt + (size_t)nxt.pn * tstep : cB;
        for (int t = 0; t < nt; t += 2) {
            const bool last = (t == nt - 2);
            const char* a1 = cA + (size_t)(t + 1) * kstep;
            const char* a2 = last ? nA : cA + (size_t)(t + 2) * kstep; const char* b2 = last ? nB : cB + (size_t)(t + 2) * kstep;
            const char* a3 = a2 + kstep; const char* b3 = b2 + kstep;
            if (last && has_next) S.a_ready(nxt);
            if constexpr (SP2) {
            PG8_LDB(B0, 0, 0); PG8_LDB(B1, 0, 1); PG8_SCHED; PG8_LDA(At, 0, 0); PG8_STAGE(PG8_SA(1, 1), a1 + hstep, voffA);
            PG8_WAIT_V(8); PG8_WAIT_L(0); PG8_BAR; PG8_MMA(0, 0, At, B0); PG8_MMA(0, 1, At, B1); PG8_BAR; PG8_SCHED;
            PG8_LDA(At, 0, 1); PG8_STAGE(PG8_SB(0, 0), b2, voffB); PG8_STAGE(PG8_SB(0, 1), b2 + hstep, voffB); PG8_STAGE(PG8_SA(0, 0), a2, voffA);
            PG8_WAIT_V(8); PG8_WAIT_L(0); PG8_BAR; PG8_MMA(1, 0, At, B0); PG8_MMA(1, 1, At, B1); PG8_BAR; PG8_SCHED;
            PG8_LDB(B0, 1, 0); PG8_LDB(B1, 1, 1); PG8_SCHED; PG8_LDA(At, 1, 0); PG8_STAGE(PG8_SA(0, 1), a2 + hstep, voffA);
            PG8_WAIT_V(8); PG8_WAIT_L(0); PG8_BAR; PG8_MMA(0, 0, At, B0); PG8_MMA(0, 1, At, B1); PG8_BAR; PG8_SCHED;
            PG8_LDA(At, 1, 1); PG8_STAGE(PG8_SB(1, 0), b3, voffB); PG8_STAGE(PG8_SB(1, 1), b3 + hstep, voffB); PG8_STAGE(PG8_SA(1, 0), a3, voffA);
            PG8_WAIT_V(8); PG8_WAIT_L(0); PG8_BAR; PG8_MMA(1, 0, At, B0); PG8_MMA(1, 1, At, B1); PG8_BAR; PG8_SCHED;
            } else {
            PG8_LDB(B0, 0, 0); PG8_SCHED; PG8_LDA(At, 0, 0); PG8_STAGE(PG8_SA(1, 1), a1 + hstep, voffA);
            PG8_WAIT_L(8); PG8_BAR; PG8_WAIT_L(0); PG8_MMA(0, 0, At, B0); PG8_BAR; PG8_SCHED;
            PG8_LDB(B1, 0, 1); PG8_STAGE(PG8_SB(0, 0), b2, voffB);
            PG8_BAR; PG8_WAIT_L(0); PG8_MMA(0, 1, At, B1); PG8_BAR;
            PG8_LDA(At, 0, 1); PG8_STAGE(PG8_SA(0, 0), a2, voffA);
            PG8_BAR; PG8_WAIT_L(0); PG8_MMA(1, 0, At, B0); PG8_BAR; PG8_SCHED;
            PG8_STAGE(PG8_SB(0, 1), b2 + hstep, voffB);
            PG8_WAIT_V(6); PG8_BAR; PG8_MMA(1, 1, At, B1); PG8_BAR;
            PG8_LDB(B0, 1, 0); PG8_SCHED; PG8_LDA(At, 1, 0); PG8_STAGE(PG8_SA(0, 1), a2 + hstep, voffA);
            PG8_WAIT_L(8); PG8_BAR; PG8_WAIT_L(0); PG8_MMA(0, 0, At, B0); PG8_BAR; PG8_SCHED;
            PG8_LDB(B1, 1, 1); PG8_STAGE(PG8_SB(1, 0), b3, voffB);
            PG8_BAR; PG8_WAIT_L(0); PG8_MMA(0, 1, At, B1); PG8_BAR;
            PG8_LDA(At, 1, 1); PG8_STAGE(PG8_SA(1, 0), a3, voffA);
            PG8_BAR; PG8_WAIT_L(0); PG8_MMA(1, 0, At, B0); PG8_BAR; PG8_SCHED;
            PG8_STAGE(PG8_SB(1, 1), b3 + hstep, voffB);
            PG8_WAIT_V(6); PG8_BAR; PG8_MMA(1, 1, At, B1); PG8_BAR;
            }
        }
        if constexpr (ALIGN_EPI) { if (wr == 0) PG8_BAR; }
        if constexpr (!Epi::AFTER_DRAIN) { E(acc, cur, wr, wc, fr, fq); S.done(cur); }
        if (!has_next) break;
#pragma unroll
        for (int a = 0; a < 2; ++a)
#pragma unroll
            for (int b = 0; b < 2; ++b)
#pragma unroll
                for (int m = 0; m < 4; ++m)
#pragma unroll
                    for (int n = 0; n < 2; ++n) acc[a][b][m][n] = (f32x4){0.f, 0.f, 0.f, 0.f};
        cur = nxt; cA = nA; cB = nB; ++ui;
        if constexpr (ALIGN_EPI) { if (wr == 1) PG8_BAR; }
    }
    PG8_WAIT_V(0);
    if constexpr (!ALIGN_EPI) { if (wr == 0) PG8_BAR; }
    PG8_BAR;
    if constexpr (Epi::AFTER_DRAIN) { E.fused(acc, cur, wr, wc, fr, fq, lds, wid, lane); S.done(cur); }
#undef PG8_SA
#undef PG8_SB
#undef PG8_STAGE
#undef PG8_LDA
#undef PG8_LDB
#undef PG8_MMA
#undef PG8_WAIT_V
#undef PG8_WAIT_L
#undef PG8_BAR
#undef PG8_SCHED
}
}


#define LAS __attribute__((address_space(3)))
using pg8::bf16_t; using pg8::bf16x8; using pg8::f32x4;
typedef unsigned u32x2 __attribute__((ext_vector_type(2)));
typedef unsigned u32x4 __attribute__((ext_vector_type(4)));

constexpr int TP = 16384, TS = 256, TT = TP + TS;
constexpr int NSLOT = 1056;
constexpr size_t MiB = 1u << 20;
constexpr size_t W_LAYER = 24 * MiB, W_IN = 0, W_OUT = 6 * MiB, W_UP = 8 * MiB, W_DOWN = 16 * MiB;
constexpr size_t WS_ACT = 48 * MiB;
constexpr size_t WS_A = WS_ACT + (size_t)TT * 1024 * 2;
constexpr size_t WS_UC = WS_A + (size_t)TT * 3072 * 2;
constexpr size_t SLOT16 = (size_t)NSLOT * 8192 * 2;
constexpr size_t WS_WC = WS_UC + SLOT16;
constexpr size_t WS_B = WS_WC + SLOT16;
constexpr size_t WS_QG = WS_B, WS_KGT = WS_QG + SLOT16, WS_ATT = WS_KGT + SLOT16;
constexpr size_t WS_MOD = WS_ATT + (size_t)NSLOT * 4096 * 2;
constexpr size_t WS_BG = WS_MOD + 2 * 16 * 6144 * 4;
constexpr size_t WS_GL = WS_BG + (size_t)TT * 8 * 4;
constexpr size_t WS_BAR = (WS_GL + NSLOT * 4 + 511) / 256 * 256;
constexpr size_t WS_END = WS_BAR + 3456 * 4 + 256;
static_assert(WS_A + (size_t)TT * 4096 * 2 <= WS_B, "hidden overlay");
static_assert(WS_B + (size_t)TT * 1024 * 2 <= WS_ATT, "hbuf overlay");
static_assert(WS_END <= 256 * MiB, "ws");
constexpr size_t O_YS = (size_t)TP * 1024, O_PCONV = O_YS + (size_t)TS * 1024, O_PDELTA = O_PCONV + 2 * 8 * 3 * 1536,
                 O_SCONV = O_PDELTA + 2 * 8 * 4 * 128 * 128, O_SDELTA = O_SCONV + 2 * 8 * 3 * 1536, O_SGUV = O_SDELTA + 2 * 8 * 4 * 128 * 128,
                 O_END = O_SGUV + 2 * 8 * 32 * 512;
constexpr int LDS_BYTES = 156 * 1024;

struct Params { const float* in[22]; float* out; unsigned char* ws; int ph_lo, ph_hi; };

typedef __bf16 hwbf2 __attribute__((ext_vector_type(2)));
typedef float f32x2_t __attribute__((ext_vector_type(2)));
__device__ __forceinline__ unsigned pk2(float lo, float hi) { const f32x2_t v = {lo, hi}; return __builtin_bit_cast(unsigned, __builtin_convertvector(v, hwbf2)); }
__device__ __forceinline__ unsigned short f2bf(float f) { return (unsigned short)(pk2(f, 0.f) & 0xffffu); }
__device__ __forceinline__ float bf2f(unsigned short b) { return __uint_as_float(((unsigned)b) << 16); }
__device__ __forceinline__ float bflo(unsigned w) { return __uint_as_float(w << 16); }
__device__ __forceinline__ float bfhi(unsigned w) { return __uint_as_float(w & 0xffff0000u); }
__device__ __forceinline__ float wave_sum(float v) {
#pragma unroll
    for (int o = 32; o >= 1; o >>= 1) v += __shfl_xor(v, o);
    return v; }
__device__ __forceinline__ float silu_f(float x) { return x * __builtin_amdgcn_rcpf(1.f + __expf(-x)); }
__device__ __forceinline__ float sigmoid_f(float x) { return __builtin_amdgcn_rcpf(1.f + __expf(-x)); }
__device__ __forceinline__ float gelu_tanh(float x) { return x * __builtin_amdgcn_rcpf(1.f + __expf(-1.5957691216f * (x + 0.044715f * x * x * x))); }
__device__ __forceinline__ int row_tb(int r) { return r < TP ? (r >> 11) : 8 + ((r - TP) >> 5); }
__device__ __forceinline__ bf16x8 mk8(unsigned a, unsigned b, unsigned c, unsigned d) { u32x4 v = {a, b, c, d}; return __builtin_bit_cast(bf16x8, v); }
__device__ __forceinline__ int tid_l() { int t = threadIdx.x; asm volatile("" : "+v"(t)); return t; }
__device__ __forceinline__ int bid_l() { int t = blockIdx.x; asm volatile("" : "+s"(t)); return t; }
__device__ __forceinline__ bf16_t* xb_ptr(const Params& P) { return (bf16_t*)((unsigned char*)P.out + (size_t)TT * 2048); }
__device__ __forceinline__ f32x4 bf4(u32x2 t) { return (f32x4){bflo(t.x), bfhi(t.x), bflo(t.y), bfhi(t.y)}; }
#define MFMA16(a, b, c) __builtin_amdgcn_mfma_f32_16x16x32_bf16((a), (b), (c), 0, 0, 0)

struct EpiP {
    static constexpr bool PERM = true, AFTER_DRAIN = false;
    bf16_t* O;
    __device__ __forceinline__ void operator()(const f32x4 (&acc)[2][2][4][2], const pg8::Unit& u, int wr, int wc, int fr, int fq) const {
        const int row0 = u.pm * 256 + wr * 64 + fr, col0 = u.pn * 256 + wc * 32 + 8 * fq; const bool act = u.pn < 4, zact = u.pn >= 10;
#pragma unroll
        for (int ai = 0; ai < 2; ++ai)
#pragma unroll
            for (int m = 0; m < 4; ++m) { bf16_t* rowp = O + (size_t)(row0 + ai * 128 + m * 16) * 3072 + col0;
#pragma unroll
                for (int bj = 0; bj < 2; ++bj) { f32x4 v0 = acc[ai][bj][m][0], v1 = acc[ai][bj][m][1];
                    if (act) {
#pragma unroll
                        for (int j = 0; j < 4; ++j) { v0[j] = gelu_tanh(v0[j]); v1[j] = gelu_tanh(v1[j]); } }
                    if (zact) {
#pragma unroll
                        for (int j = 0; j < 4; ++j) { v0[j] = silu_f(v0[j]); v1[j] = silu_f(v1[j]); } }
                    u32x4 w; w.x = pg8::cvt_pk_bf16(v0[0], v0[1]); w.y = pg8::cvt_pk_bf16(v0[2], v0[3]); w.z = pg8::cvt_pk_bf16(v1[0], v1[1]); w.w = pg8::cvt_pk_bf16(v1[2], v1[3]);
                    *(u32x4*)(rowp + bj * 128) = w; } }
    }
    __device__ __forceinline__ void row8(int r, int c, const float (&v)[8]) const {
        float t[8];
#pragma unroll
        for (int j = 0; j < 8; ++j) t[j] = c < 1024 ? gelu_tanh(v[j]) : (c >= 2560 ? silu_f(v[j]) : v[j]);
        u32x4 w; w.x = pk2(t[0], t[1]); w.y = pk2(t[2], t[3]); w.z = pk2(t[4], t[5]); w.w = pk2(t[6], t[7]);
        *(u32x4*)(O + (size_t)r * 3072 + c) = w; }
};
struct EpiH {
    static constexpr bool PERM = true, AFTER_DRAIN = false;
    bf16_t* O;
    __device__ __forceinline__ void operator()(const f32x4 (&acc)[2][2][4][2], const pg8::Unit& u, int wr, int wc, int fr, int fq) const {
        const int row0 = u.pm * 256 + wr * 64 + fr, col0 = u.pn * 256 + wc * 32 + 8 * fq;
#pragma unroll
        for (int ai = 0; ai < 2; ++ai)
#pragma unroll
            for (int m = 0; m < 4; ++m) { bf16_t* rowp = O + (size_t)(row0 + ai * 128 + m * 16) * 4096 + col0;
#pragma unroll
                for (int bj = 0; bj < 2; ++bj) { f32x4 v0 = acc[ai][bj][m][0], v1 = acc[ai][bj][m][1];
#pragma unroll
                    for (int j = 0; j < 4; ++j) { const float a = fmaxf(v0[j], 0.f), b = fmaxf(v1[j], 0.f); v0[j] = a * a; v1[j] = b * b; }
                    u32x4 w; w.x = pg8::cvt_pk_bf16(v0[0], v0[1]); w.y = pg8::cvt_pk_bf16(v0[2], v0[3]); w.z = pg8::cvt_pk_bf16(v1[0], v1[1]); w.w = pg8::cvt_pk_bf16(v1[2], v1[3]);
                    *(u32x4*)(rowp + bj * 128) = w; } }
    }
    __device__ __forceinline__ void row8(int r, int c, const float (&v)[8]) const {
        float t[8];
#pragma unroll
        for (int j = 0; j < 8; ++j) { const float a = fmaxf(v[j], 0.f); t[j] = a * a; }
        u32x4 w; w.x = pk2(t[0], t[1]); w.y = pk2(t[2], t[3]); w.z = pk2(t[4], t[5]); w.w = pk2(t[6], t[7]);
        *(u32x4*)(O + (size_t)r * 4096 + c) = w; }
};
struct EpiRes {
    static constexpr bool PERM = true, AFTER_DRAIN = false;
    const float* base_p; const float* base_s; bf16_t* xb; const float* gate; int basef32;
    __device__ __forceinline__ void operator()(const f32x4 (&acc)[2][2][4][2], const pg8::Unit& u, int wr, int wc, int fr, int fq) const {
        const int row0 = u.pm * 256 + wr * 64 + fr, col0 = u.pn * 256 + wc * 32 + 8 * fq;
#pragma unroll
        for (int ai = 0; ai < 2; ++ai)
#pragma unroll
            for (int m = 0; m < 4; ++m) { const int r = row0 + ai * 128 + m * 16; const float* gp = gate + row_tb(r) * 6144; bf16_t* xr = xb + (size_t)r * 1024;
#pragma unroll
                for (int bj = 0; bj < 2; ++bj) { const int c = col0 + bj * 128; const f32x4 g0 = *(const f32x4*)(gp + c), g1 = *(const f32x4*)(gp + c + 4); f32x4 b0, b1;
                    if (basef32) { const float* bp = (r < TP) ? base_p + (size_t)r * 1024 : base_s + (size_t)(r - TP) * 1024; b0 = *(const f32x4*)(bp + c); b1 = *(const f32x4*)(bp + c + 4); }
                    else { const u32x4 raw = *(const u32x4*)(xr + c); b0 = bf4((u32x2){raw.x, raw.y}); b1 = bf4((u32x2){raw.z, raw.w}); }
                    const f32x4 x0 = b0 + g0 * acc[ai][bj][m][0], x1 = b1 + g1 * acc[ai][bj][m][1];
                    *(u32x4*)(xr + c) = (u32x4){pk2(x0[0], x0[1]), pk2(x0[2], x0[3]), pk2(x1[0], x1[1]), pk2(x1[2], x1[3])}; }
                if (m & 1) asm volatile("" ::: "memory"); }
    }
    __device__ __forceinline__ void row8(int r, int c, const float (&v)[8]) const {
        const float* gp = gate + row_tb(r) * 6144 + c; bf16_t* xr = xb + (size_t)r * 1024 + c;
        const f32x4 g0 = *(const f32x4*)gp, g1 = *(const f32x4*)(gp + 4); f32x4 b0, b1;
        if (basef32) { const float* bp = base_s + (size_t)(r - TP) * 1024 + c; b0 = *(const f32x4*)bp; b1 = *(const f32x4*)(bp + 4); }
        else { const u32x4 raw = *(const u32x4*)xr; b0 = bf4((u32x2){raw.x, raw.y}); b1 = bf4((u32x2){raw.z, raw.w}); }
        const f32x4 x0 = b0 + g0 * (f32x4){v[0], v[1], v[2], v[3]}, x1 = b1 + g1 * (f32x4){v[4], v[5], v[6], v[7]};
        *(u32x4*)xr = (u32x4){pk2(x0[0], x0[1]), pk2(x0[2], x0[3]), pk2(x1[0], x1[1]), pk2(x1[2], x1[3])}; }
};
template <bool ALIGN, class Epi> __device__ __forceinline__ void run_gemm(LAS unsigned char* lds, const bf16_t* A, const bf16_t* Bt, int N, int K, const Epi& E) {
    pg8::Gemm g; g.A = A; g.Bt = Bt; g.M = TP; g.N = N; g.K = K;
    pg8::StaticOrder S; S.init(TP, N, (int)gridDim.x, bid_l());
    pg8::gemm_phase<Epi, pg8::StaticOrder, ALIGN, true>(lds, g, S, E);
}
template <int TM, int TN, int UNR, class Epi> __device__ __forceinline__ void small_gemm(LAS unsigned char* lds, const bf16_t* A, const bf16_t* Bt, int N, int K, const Epi& E) {
    constexpr int MT = TM / 16, NT = TN / 16;
    const int tid = tid_l(), lane = tid & 63, wave = tid >> 6, x = lane & 15, kq = lane >> 4;
    const int ntn = N / TN, ntiles = (TS / TM) * ntn, kw = K / 8;
    LAS float* red = (LAS float*)lds;
    for (int t = bid_l(); t < ntiles; t += gridDim.x) {
        const int tm = t / ntn, tn = t - tm * ntn;
        const bf16_t* ap = A + (size_t)(TP + tm * TM + x) * K + wave * kw + kq * 8;
        const bf16_t* bp = Bt + (size_t)(tn * TN + x) * K + wave * kw + kq * 8;
        f32x4 acc[NT][MT];
#pragma unroll
        for (int nt = 0; nt < NT; ++nt)
#pragma unroll
            for (int mt = 0; mt < MT; ++mt) acc[nt][mt] = (f32x4){0.f, 0.f, 0.f, 0.f};
        for (int ks0 = 0; ks0 < kw / 32; ks0 += UNR) {
            bf16x8 af[UNR][MT], bfr[UNR][NT];
#pragma unroll
            for (int j = 0; j < UNR; ++j) {
#pragma unroll
                for (int mt = 0; mt < MT; ++mt) af[j][mt] = *(const bf16x8*)(ap + (size_t)mt * 16 * K + (ks0 + j) * 32);
#pragma unroll
                for (int nt = 0; nt < NT; ++nt) bfr[j][nt] = *(const bf16x8*)(bp + (size_t)nt * 16 * K + (ks0 + j) * 32); }
            __builtin_amdgcn_sched_barrier(0);
#pragma unroll
            for (int j = 0; j < UNR; ++j)
#pragma unroll
                for (int nt = 0; nt < NT; ++nt)
#pragma unroll
                    for (int mt = 0; mt < MT; ++mt) acc[nt][mt] = MFMA16(bfr[j][nt], af[j][mt], acc[nt][mt]);
            __builtin_amdgcn_sched_barrier(0);
        }
#pragma unroll
        for (int nt = 0; nt < NT; ++nt)
#pragma unroll
            for (int mt = 0; mt < MT; ++mt) *(LAS f32x4*)(red + wave * TM * TN + (16 * mt + x) * TN + 16 * nt + kq * 4) = acc[nt][mt];
        __syncthreads();
        if (tid < TM * TN / 8) { const int r = tid / (TN / 8), c8 = (tid % (TN / 8)) * 8; float v[8];
#pragma unroll
            for (int j = 0; j < 8; ++j) v[j] = 0.f;
#pragma unroll
            for (int w = 0; w < 8; ++w) { const f32x4 a = *(const LAS f32x4*)(red + w * TM * TN + r * TN + c8), c = *(const LAS f32x4*)(red + w * TM * TN + r * TN + c8 + 4);
                v[0] += a[0]; v[1] += a[1]; v[2] += a[2]; v[3] += a[3]; v[4] += c[0]; v[5] += c[1]; v[6] += c[2]; v[7] += c[3]; }
            E.row8(TP + tm * TM + r, tn * TN + c8, v); }
        __syncthreads();
    }
}

__device__ __forceinline__ void transpose_tile4(const float* W, int ldw, bf16_t* Bt, int ldb, int k0, int n0, LAS float* tile  ) {
    const int tid = tid_l(), ty = tid >> 6, tx = tid & 63;
    f32x4 v[8];
#pragma unroll
    for (int i = 0; i < 8; ++i) v[i] = *(const f32x4*)(W + (size_t)(k0 + ty + 8 * i) * ldw + n0 + tx * 4);
#pragma unroll
    for (int i = 0; i < 8; ++i) { const int k = ty + 8 * i; tile[k * 261 + tx * 4 + 0] = v[i][0]; tile[k * 261 + tx * 4 + 1] = v[i][1]; tile[k * 261 + tx * 4 + 2] = v[i][2]; tile[k * 261 + tx * 4 + 3] = v[i][3]; }
    __syncthreads();
#pragma unroll
    for (int i = 0; i < 4; ++i) { const int n = (tid >> 3) + 64 * i, kq = tid & 7; u32x4 w;
        w.x = pk2(tile[(kq * 8 + 0) * 261 + n], tile[(kq * 8 + 1) * 261 + n]); w.y = pk2(tile[(kq * 8 + 2) * 261 + n], tile[(kq * 8 + 3) * 261 + n]);
        w.z = pk2(tile[(kq * 8 + 4) * 261 + n], tile[(kq * 8 + 5) * 261 + n]); w.w = pk2(tile[(kq * 8 + 6) * 261 + n], tile[(kq * 8 + 7) * 261 + n]);
        *(u32x4*)(Bt + (size_t)(n0 + n) * ldb + k0 + kq * 8) = w; }
    __syncthreads();
}
__device__ __forceinline__ void phase0(const Params& P, LAS unsigned char* lds) {
    const int tid = tid_l(), lane = tid & 63, wave = tid >> 6, G = gridDim.x, bid = bid_l();
    float* mod = (float*)(P.ws + WS_MOD);
    if (bid < 192) {
        LAS float* cs = (LAS float*)lds;
        LAS float* red = (LAS float*)(lds + 65536);
        for (int i = tid; i < 16384; i += 512) { const int tb = i >> 10, k = i & 1023; const float c = tb < 8 ? P.in[2][tb * 1024 + k] : P.in[3][(tb - 8) * 1024 + k]; cs[k * 16 + tb] = silu_f(c); }
        __syncthreads();
        for (int item = bid; item < 192; item += G) {
            const int l = item / 96, cgp = item % 96, j = cgp * 64 + lane;
            const float* wp = P.in[6] + ((size_t)l * 1024 + wave * 128) * 6144 + j;
            float acc[16];
#pragma unroll
            for (int t = 0; t < 16; ++t) acc[t] = 0.f;
#pragma unroll 16
            for (int kk = 0; kk < 128; ++kk) { const float wv = wp[(size_t)kk * 6144]; const LAS f32x4* c4 = (const LAS f32x4*)(cs + (wave * 128 + kk) * 16);
#pragma unroll
                for (int q = 0; q < 4; ++q) { const f32x4 cv = c4[q]; acc[4 * q + 0] += cv[0] * wv; acc[4 * q + 1] += cv[1] * wv; acc[4 * q + 2] += cv[2] * wv; acc[4 * q + 3] += cv[3] * wv; } }
#pragma unroll
            for (int t = 0; t < 16; ++t) red[(wave * 16 + t) * 64 + lane] = acc[t];
            __syncthreads();
            for (int o = tid; o < 1024; o += 512) { const int tb = o >> 6, ln = o & 63; float s = P.in[7][l * 6144 + cgp * 64 + ln];
#pragma unroll
                for (int w = 0; w < 8; ++w) s += red[(w * 16 + tb) * 64 + ln];
                mod[(size_t)(l * 16 + tb) * 6144 + cgp * 64 + ln] = s; }
            __syncthreads();
        }
    }
    __syncthreads();
    LAS float* tile = (LAS float*)lds;
    for (int it = bid; it < 1536; it += G) {
        const int l = it / 768; int r = it % 768; const float* W; int ldw, K, kt, nt; bf16_t* Bt;
        if (r < 192) { W = P.in[10] + (size_t)l * 1024 * 3080; ldw = 3080; K = 1024; Bt = (bf16_t*)(P.ws + l * W_LAYER + W_IN); kt = r / 12; nt = r % 12; }
        else if (r < 256) { r -= 192; W = P.in[18] + (size_t)l * 1024 * 1024; ldw = 1024; K = 1024; Bt = (bf16_t*)(P.ws + l * W_LAYER + W_OUT); kt = r / 4; nt = r % 4; }
        else if (r < 512) { r -= 256; W = P.in[19] + (size_t)l * 1024 * 4096; ldw = 4096; K = 1024; Bt = (bf16_t*)(P.ws + l * W_LAYER + W_UP); kt = r / 16; nt = r % 16; }
        else { r -= 512; W = P.in[20] + (size_t)l * 4096 * 1024; ldw = 1024; K = 4096; Bt = (bf16_t*)(P.ws + l * W_LAYER + W_DOWN); kt = r / 4; nt = r % 4; }
        transpose_tile4(W, ldw, Bt, K, kt * 64, nt * 256, tile);
    }
}

template <bool MIX> __device__ __forceinline__ void phase_h(const Params& P, int l, LAS unsigned char* lds) {
    const int tid = tid_l(), lane = tid & 63, wave = tid >> 6;
    const float* gamma = (MIX ? P.in[8] : P.in[9]) + l * 1024;
    const float* mod = (const float*)(P.ws + WS_MOD) + (size_t)l * 16 * 6144;
    const int shoff = MIX ? 0 : 3072, scoff = MIX ? 1024 : 4096;
    bf16_t* hbuf = (bf16_t*)(P.ws + WS_B);
    float* bg = (float*)(P.ws + WS_BG);
    const float* wab = P.in[10] + (size_t)l * 1024 * 3080 + 3072;
    LAS float* wT = (LAS float*)lds;
    if (MIX) {
#pragma unroll
        for (int i = 0; i < 2; ++i) { const int j = tid + 512 * i; const f32x4 w0 = *(const f32x4*)(wab + (size_t)j * 3080), w1 = *(const f32x4*)(wab + (size_t)j * 3080 + 4);
            wT[j] = w0[0]; wT[1024 + j] = w0[1]; wT[2048 + j] = w0[2]; wT[3072 + j] = w0[3]; wT[4096 + j] = w1[0]; wT[5120 + j] = w1[1]; wT[6144 + j] = w1[2]; wT[7168 + j] = w1[3]; }
        __syncthreads();
    }
    const int gw = bid_l() * 8 + wave;
    const bf16_t* xbp = xb_ptr(P);
#define LOADROW(dst, r_) do { if (MIX && l == 0) { const float* xr_ = (r_) < TP ? P.in[0] + (size_t)(r_) * 1024 : P.in[1] + (size_t)((r_) - TP) * 1024; \
            _Pragma("unroll") for (int i_ = 0; i_ < 4; ++i_) dst[i_] = *(const f32x4*)(xr_ + lane * 4 + 256 * i_); } \
        else { const bf16_t* xr_ = xbp + (size_t)(r_) * 1024; _Pragma("unroll") for (int i_ = 0; i_ < 4; ++i_) dst[i_] = bf4(*(const u32x2*)(xr_ + lane * 4 + 256 * i_)); } } while (0)
#define LOAD_MOD(tb_) do { const float* mp_ = mod + (tb_) * 6144; _Pragma("unroll") for (int i_ = 0; i_ < 4; ++i_) { const int j_ = lane * 4 + 256 * i_; \
        const f32x4 g4_ = *(const f32x4*)(gamma + j_), sc4_ = *(const f32x4*)(mp_ + scoff + j_); csv[i_] = g4_ * (sc4_ + 1.f); shv[i_] = *(const f32x4*)(mp_ + shoff + j_); } } while (0)
    if (gw * 8 >= TP) return;
    f32x4 csv[4], shv[4], v[4];
    LOADROW(v, gw * 8);
    LOAD_MOD((gw * 8) >> 11);
    const int nrows = gw < TS ? 9 : 8;
    for (int it = 0; it < nrows; ++it) {
        const int r = it < 8 ? gw * 8 + it : TP + gw;
        f32x4 vnx[4];
        if (it + 1 < nrows) LOADROW(vnx, (it + 1 < 8 ? gw * 8 + it + 1 : TP + gw));
        if (it == 8) LOAD_MOD(8 + (gw >> 5));
        float ss = 0.f;
#pragma unroll
        for (int i = 0; i < 4; ++i) ss += v[i][0] * v[i][0] + v[i][1] * v[i][1] + v[i][2] * v[i][2] + v[i][3] * v[i][3];
        ss = wave_sum(ss);
        const float rstd = rsqrtf(ss * (1.f / 1024.f) + 1e-6f);
        float ab[8];
#pragma unroll
        for (int e = 0; e < 8; ++e) ab[e] = 0.f;
#pragma unroll
        for (int i = 0; i < 4; ++i) { const int j = lane * 4 + 256 * i;
            const f32x4 hv = v[i] * rstd * csv[i] + shv[i];
            u32x2 w; w.x = pk2(hv[0], hv[1]); w.y = pk2(hv[2], hv[3]);
            *(u32x2*)(hbuf + (size_t)r * 1024 + j) = w;
            if (MIX) {
#pragma unroll
                for (int c = 0; c < 8; ++c) { const f32x4 w4 = *(const LAS f32x4*)(wT + c * 1024 + j); ab[c] += hv[0] * w4[0] + hv[1] * w4[1] + hv[2] * w4[2] + hv[3] * w4[3]; }
                __builtin_amdgcn_sched_barrier(0); }
        }
        if (MIX) {
            const bool h1 = lane & 32, h2 = lane & 16, h3 = lane & 8;
            float k4[4], k2[2];
#pragma unroll
            for (int i = 0; i < 4; ++i) { const float send = h1 ? ab[i] : ab[4 + i]; k4[i] = (h1 ? ab[4 + i] : ab[i]) + __shfl_xor(send, 32); }
#pragma unroll
            for (int i = 0; i < 2; ++i) { const float send = h2 ? k4[i] : k4[2 + i]; k2[i] = (h2 ? k4[2 + i] : k4[i]) + __shfl_xor(send, 16); }
            float k1 = (h3 ? k2[1] : k2[0]) + __shfl_xor(h3 ? k2[0] : k2[1], 8);
            k1 += __shfl_xor(k1, 4); k1 += __shfl_xor(k1, 2); k1 += __shfl_xor(k1, 1);
            if ((lane & 7) == 0) { const int idx = lane >> 3, h = idx & 3;
                if (idx < 4) bg[(size_t)r * 8 + h] = sigmoid_f(k1);
                else { const float xx = k1 + P.in[15][l * 4 + h]; const float sp = xx > 20.f ? xx : log1pf(expf(xx)); bg[(size_t)r * 8 + 4 + h] = -expf(P.in[16][l * 4 + h]) * sp; } }
        }
#pragma unroll
        for (int i = 0; i < 4; ++i) v[i] = vnx[i];
    }
#undef LOADROW
#undef LOAD_MOD
}

template <int C> struct B1Raw { static constexpr int NCH = (C + 3) * 48, NB = (NCH + 511) / 512; };
template <int C> __device__ __forceinline__ void b1_issue(const Params& P, int l, int it, int tid, u32x4 (&rv)[B1Raw<C>::NB]) {
    const bool sample = it >= 1024; const int bh = sample ? it - 1024 : it >> 5, ci = sample ? 0 : it & 31, b = bh >> 2, h = bh & 3;
    const int row0 = sample ? TP + b * 32 : b * 2048 + ci * 64; const bool first = ci == 0;
    const bf16_t* p = (const bf16_t*)(P.ws + WS_A);
#pragma unroll
    for (int i = 0; i < B1Raw<C>::NB; ++i) { const int idx = tid + 512 * i; rv[i] = (u32x4){0u, 0u, 0u, 0u};
        if (idx < B1Raw<C>::NCH) { const int rr = idx / 48, cc = idx - rr * 48, tt = rr - 3, ch = (cc >> 4) * 512 + h * 128 + (cc & 15) * 8;
            if (tt >= 0 || !first) rv[i] = *(const u32x4*)(p + (size_t)(row0 + tt) * 3072 + 1024 + ch);
            else if (sample) { const float* sp = P.in[4] + ((size_t)(l * 8 + b) * 3 + rr) * 1536 + ch; const f32x4 a = *(const f32x4*)sp, c4 = *(const f32x4*)(sp + 4);
                rv[i] = (u32x4){pk2(a[0], a[1]), pk2(a[2], a[3]), pk2(c4[0], c4[1]), pk2(c4[2], c4[3])}; } } }
}
template <int C> __device__ __forceinline__ void b1_item(const Params& P, int l, int it, int nxt, u32x4 (&rv)[B1Raw<C>::NB], LAS unsigned char* lds) {
    constexpr int NT = C / 16;
    const int tid = tid_l(), lane = tid & 63, wave = tid >> 6;
    const bool sample = it >= 1024; const int slot = it, bh = sample ? it - 1024 : it >> 5, ci = sample ? 0 : it & 31, b = bh >> 2, h = bh & 3;
    const int row0 = sample ? TP + b * 32 : b * 2048 + ci * 64; const bool last = sample || ci == 31;
    LAS float* F0 = (LAS float*)lds;
    LAS float* F1 = (LAS float*)(lds + 33792);
    LAS float* F2 = (LAS float*)(lds + 67584);
    LAS bf16_t* QB = (LAS bf16_t*)(lds + 101376);
    LAS bf16_t* KB = (LAS bf16_t*)(lds + 118784);
    LAS bf16_t* KBB = (LAS bf16_t*)(lds + 136192);
    LAS float* rn = (LAS float*)(lds + 153600);
    LAS float* betas = rn + 128;
    LAS float* gcs = betas + 64;
    LAS float* egs = gcs + 64;
    LAS float* egls = egs + 64;
    const float* bg = (const float*)(P.ws + WS_BG);
    bf16_t* UC = (bf16_t*)(P.ws + WS_UC) + (size_t)slot * 8192; bf16_t* WC = (bf16_t*)(P.ws + WS_WC) + (size_t)slot * 8192;
    bf16_t* QG = (bf16_t*)(P.ws + WS_QG) + (size_t)slot * 8192; bf16_t* KGT = (bf16_t*)(P.ws + WS_KGT) + (size_t)slot * 8192;
    bf16_t* ATT = (bf16_t*)(P.ws + WS_ATT) + (size_t)slot * 4096;
    LAS bf16_t* RAW = QB;
#pragma unroll
    for (int i = 0; i < B1Raw<C>::NB; ++i) { const int idx = tid + 512 * i; if (idx < B1Raw<C>::NCH) *(LAS u32x4*)(RAW + idx * 8) = rv[i]; }
    __syncthreads();
    if (nxt >= 0) b1_issue<C>(P, l, nxt, tid, rv);
    if (tid < 384) {
        const int c = tid, which = c >> 7, d = c & 127, ch = which * 512 + h * 128 + d;
        const float* cw = P.in[14] + (size_t)l * 4 * 1536 + ch;
        const float w0 = cw[0], w1 = cw[1536], w2 = cw[3072], w3 = cw[4608];
        LAS float* F = which == 0 ? F0 : (which == 1 ? F1 : F2);
        float x0 = bf2f(RAW[c]), x1 = bf2f(RAW[384 + c]), x2 = bf2f(RAW[768 + c]);
#pragma unroll 8
        for (int t = 0; t < C; ++t) { const float x3 = bf2f(RAW[(t + 3) * 384 + c]); F[t * 132 + d] = silu_f(w0 * x0 + w1 * x1 + w2 * x2 + w3 * x3); x0 = x1; x1 = x2; x2 = x3; }
        if (last) { float* oc = P.out + (sample ? O_SCONV : O_PCONV) + (size_t)(l * 8 + b) * 3 * 1536;
            oc[ch] = x0; oc[1536 + ch] = x1; oc[3072 + ch] = x2; }
    } else if (wave == 6) {
        float gv = lane < C ? bg[(size_t)(row0 + lane) * 8 + 4 + h] : 0.f;
#pragma unroll
        for (int dd = 1; dd < 64; dd <<= 1) { const float n = __shfl_up(gv, dd); if (lane >= dd) gv += n; }
        const float gl_ = __shfl(gv, C - 1);
        if (lane < C) { gcs[lane] = gv; betas[lane] = bg[(size_t)(row0 + lane) * 8 + h]; egs[lane] = __expf(gv); egls[lane] = __expf(gl_ - gv); }
        if (lane == 0) ((float*)(P.ws + WS_GL))[slot] = __expf(gl_);
    }
    __syncthreads();
#pragma unroll
    for (int i = 0; i < (2 * C * 8) / 512; ++i) { const int idx = tid + 512 * i, ar = idx >> 3, part = idx & 7; const LAS float* src = (ar < C ? F0 + ar * 132 : F1 + (ar - C) * 132) + part * 16; float ss = 0.f;
#pragma unroll
        for (int j = 0; j < 4; ++j) { const f32x4 v = *(const LAS f32x4*)(src + 4 * j); ss += v[0] * v[0] + v[1] * v[1] + v[2] * v[2] + v[3] * v[3]; }
        ss += __shfl_xor(ss, 1); ss += __shfl_xor(ss, 2); ss += __shfl_xor(ss, 4);
        if (part == 0) rn[ar] = rsqrtf(ss + 1e-6f) * (ar < C ? 0.08838834764831845f : 1.f); }
    __syncthreads();
#pragma unroll
    for (int i = 0; i < (C * 32) / 512; ++i) { const int idx = tid + 512 * i, t = idx >> 5, d = (idx & 31) * 4;
        const f32x4 q4 = *(const LAS f32x4*)(F0 + t * 132 + d), k4 = *(const LAS f32x4*)(F1 + t * 132 + d), v4 = *(const LAS f32x4*)(F2 + t * 132 + d);
        const float rq = rn[t], rk = rn[C + t], bt = betas[t], eg = egs[t];
        const f32x4 qn = q4 * rq, kn = k4 * rk, kbt = kn * bt;
        *(LAS u32x2*)(QB + t * 136 + d) = (u32x2){pk2(qn[0], qn[1]), pk2(qn[2], qn[3])};
        *(LAS u32x2*)(KB + t * 136 + d) = (u32x2){pk2(kn[0], kn[1]), pk2(kn[2], kn[3])};
        *(LAS u32x2*)(KBB + t * 136 + d) = (u32x2){pk2(kbt[0], kbt[1]), pk2(kbt[2], kbt[3])};
        const f32x4 qe = qn * eg; *(u32x2*)(QG + t * 128 + d) = (u32x2){pk2(qe[0], qe[1]), pk2(qe[2], qe[3])};
        *(LAS f32x4*)(F0 + t * 132 + d) = kbt * eg; *(LAS f32x4*)(F2 + t * 132 + d) = v4 * bt; }
#pragma unroll
    for (int i = 0; i < (C * 16) / 512; ++i) { const int idx = tid + 512 * i, d = idx & 127, tg = idx >> 7; float kv[8];
#pragma unroll
        for (int j = 0; j < 8; ++j) { const int t = tg * 8 + j; kv[j] = F1[t * 132 + d] * rn[C + t] * egls[t]; }
        *(u32x4*)(KGT + d * 64 + tg * 8) = (u32x4){pk2(kv[0], kv[1]), pk2(kv[2], kv[3]), pk2(kv[4], kv[5]), pk2(kv[6], kv[7])}; }
    __syncthreads();
    LAS float* AdT = F1;
    LAS bf16_t* Abf = (LAS bf16_t*)(lds + 33792 + 4352);
    LAS float* UL = (LAS float*)(lds + 33792 + 13568);
    if (wave < 2 * NT) {
        const int prod = wave / NT, ti = wave % NT, m = lane & 15, kq = lane >> 4;
        const LAS bf16_t* Asrc = prod == 0 ? KBB : QB;
        for (int tj = 0; tj < NT; ++tj) {
            if (prod == 0 && tj > ti) break;
            f32x4 acc = {0.f, 0.f, 0.f, 0.f};
            if (tj <= ti) {
#pragma unroll
                for (int s = 0; s < 4; ++s) { const bf16x8 a = *(const LAS bf16x8*)(Asrc + (16 * ti + m) * 136 + 32 * s + kq * 8), bb = *(const LAS bf16x8*)(KB + (16 * tj + m) * 136 + 32 * s + kq * 8);
                    acc = MFMA16(a, bb, acc); }
            }
            const int j = 16 * tj + m; const float gj = gcs[j];
#pragma unroll
            for (int r = 0; r < 4; ++r) { const int i = 16 * ti + kq * 4 + r; const float dec = __expf(fminf(gcs[i] - gj, 0.f));
                if (prod == 0) { const float a = (i > j) ? acc[r] * dec : 0.f;
                    if (tj == ti) AdT[(ti * 16 + m) * 16 + kq * 4 + r] = a; else Abf[i * 72 + j] = f2bf(a); }
                else ATT[i * 64 + j] = f2bf((i >= j) ? acc[r] * dec : 0.f); }
        }
    }
    __syncthreads();
    {
        LAS bf16_t* XT = QB;
        const int c = tid & 255; const LAS float* rhs = (c < 128) ? (F2 + c) : (F0 + (c - 128));
        bf16_t* dst = ((c < 128) ? UC : WC) + (c & 127);
        int zoff; asm volatile("v_mov_b32 %0, 0" : "=v"(zoff));
        const LAS float* Az = AdT + zoff * 4;
        const int m = lane & 15, kq = lane >> 4;
#pragma unroll
        for (int bk = 0; bk < NT; ++bk) {
            if (bk > 0) {
#pragma unroll
                for (int cti = 0; cti < 2; ++cti) { const int ct = wave * 2 + cti; f32x4 acc = {0.f, 0.f, 0.f, 0.f};
#pragma unroll
                    for (int s = 0; s < (bk + 1) / 2; ++s) { const bool on = (32 * s + kq * 8) < 16 * bk;
                        u32x4 xa = *(const LAS u32x4*)(XT + (16 * ct + m) * 72 + 32 * s + kq * 8), ab = *(const LAS u32x4*)(Abf + (16 * bk + m) * 72 + 32 * s + kq * 8);
                        if (!on) { xa = (u32x4){0u, 0u, 0u, 0u}; ab = (u32x4){0u, 0u, 0u, 0u}; }
                        acc = MFMA16(__builtin_bit_cast(bf16x8, xa), __builtin_bit_cast(bf16x8, ab), acc); }
                    *(LAS f32x4*)(UL + m * 260 + 16 * ct + kq * 4) = acc; }
                __syncthreads();
            }
            if (tid < 256) {
                float x[16];
#pragma unroll
                for (int i = 0; i < 16; ++i) x[i] = rhs[(16 * bk + i) * 132] - (bk > 0 ? UL[i * 260 + c] : 0.f);
#pragma unroll
                for (int j = 0; j < 15; ++j)
#pragma unroll
                    for (int i = j + 1; i < 16; ++i) x[i] -= Az[(bk * 16 + j) * 16 + i] * x[j];
                const u32x4 w0 = {pk2(x[0], x[1]), pk2(x[2], x[3]), pk2(x[4], x[5]), pk2(x[6], x[7])}, w1 = {pk2(x[8], x[9]), pk2(x[10], x[11]), pk2(x[12], x[13]), pk2(x[14], x[15])};
                *(LAS u32x4*)(XT + c * 72 + 16 * bk) = w0; *(LAS u32x4*)(XT + c * 72 + 16 * bk + 8) = w1;
                if (c < 128) {
                    bf16_t* uf = UC + ((((c >> 4) * 4 + bk) * 64) + (c & 15)) * 4;
                    *(u32x2*)(uf) = (u32x2){w0[0], w0[1]}; *(u32x2*)(uf + 64) = (u32x2){w0[2], w0[3]}; *(u32x2*)(uf + 128) = (u32x2){w1[0], w1[1]}; *(u32x2*)(uf + 192) = (u32x2){w1[2], w1[3]};
                } else {
#pragma unroll
                    for (int i = 0; i < 4; ++i) { dst[(16 * bk + 2 * i) * 128] = (bf16_t)(w0[i] & 0xffffu); dst[(16 * bk + 2 * i + 1) * 128] = (bf16_t)(w0[i] >> 16);
                        dst[(16 * bk + 8 + 2 * i) * 128] = (bf16_t)(w1[i] & 0xffffu); dst[(16 * bk + 8 + 2 * i + 1) * 128] = (bf16_t)(w1[i] >> 16); } }
            }
            __syncthreads();
        }
    }
}
__device__ __forceinline__ void phase_b1(const Params& P, int l, LAS unsigned char* lds) {
    const int tid = tid_l(), G = gridDim.x; int it = bid_l();
    {
        u32x4 rv[B1Raw<64>::NB];
        if (it < 1024) b1_issue<64>(P, l, it, tid, rv);
        for (; it < 1024; it += G) { const int nx = it + G; b1_item<64>(P, l, it, nx < 1024 ? nx : -1, rv, lds); }
    }
    for (; it < NSLOT; it += G) { u32x4 rs[B1Raw<32>::NB]; b1_issue<32>(P, l, it, tid, rs); b1_item<32>(P, l, it, -1, rs, lds); }
}

__device__ __forceinline__ bf16x8 ldA(const LAS bf16_t* X, int ld, int row, int s, int kq) {
    const u32x2 lo = *(const LAS u32x2*)(X + row * ld + 32 * s + kq * 4), hi = *(const LAS u32x2*)(X + row * ld + 32 * s + 16 + kq * 4);
    return mk8(lo.x, lo.y, hi.x, hi.y); }
__device__ __forceinline__ bf16x8 packB(const f32x4& a, const f32x4& b) { return mk8(pk2(a[0], a[1]), pk2(a[2], a[3]), pk2(b[0], b[1]), pk2(b[2], b[3])); }
template <int C> __device__ __forceinline__ void scan_job(const Params& P, int l, int bh, int q, bool sample, LAS unsigned char* lds) {
    constexpr int MT = C / 16, KS = C / 32, NB3 = C / 32, BUF = 62464;
    const int tid = tid_l(), lane = tid & 63, wave = tid >> 6, m = lane & 15, kq = lane >> 4, b = bh >> 2, h = bh & 3;
    const bool active = wave < 2; const int ct = q * 2 + (wave & 1), vcol = ct * 16 + m;
    bf16_t* mixcat = (bf16_t*)(P.ws + WS_ACT);
    f32x4 S[8];
    if (sample && active) { const float* sd = P.in[5] + ((size_t)(l * 8 + b) * 4 + h) * 16384;
#pragma unroll
        for (int kt = 0; kt < 8; ++kt)
#pragma unroll
            for (int r = 0; r < 4; ++r) S[kt][r] = sd[(16 * kt + kq * 4 + r) * 128 + vcol];
    } else {
#pragma unroll
        for (int kt = 0; kt < 8; ++kt) S[kt] = (f32x4){0.f, 0.f, 0.f, 0.f};
    }
    const int nch = sample ? 1 : 32;
    u32x4 pfW[NB3], pfQ[NB3], pfA, pfK[2]; float glp;
#define SCAN_ISSUE(ci_) do { const int slot_ = sample ? 1024 + bh : bh * 32 + (ci_); \
        const bf16_t* gWC = (const bf16_t*)(P.ws + WS_WC) + (size_t)slot_ * 8192; const bf16_t* gQG = (const bf16_t*)(P.ws + WS_QG) + (size_t)slot_ * 8192; \
        const bf16_t* gKG = (const bf16_t*)(P.ws + WS_KGT) + (size_t)slot_ * 8192; \
        const bf16_t* gAT = (const bf16_t*)(P.ws + WS_ATT) + (size_t)slot_ * 4096; \
        _Pragma("unroll") for (int i_ = 0; i_ < NB3; ++i_) { const int idx_ = tid + 512 * i_, r_ = idx_ >> 4, c8_ = (idx_ & 15) * 8; \
            pfW[i_] = *(const u32x4*)(gWC + r_ * 128 + c8_); pfQ[i_] = *(const u32x4*)(gQG + r_ * 128 + c8_); } \
        if (tid < C * 8) pfA = *(const u32x4*)(gAT + (tid >> 3) * 64 + (tid & 7) * 8); \
        _Pragma("unroll") for (int i_ = 0; i_ < 2; ++i_) { const int idx_ = tid + 512 * i_; pfK[i_] = *(const u32x4*)(gKG + (idx_ >> 3) * 64 + (idx_ & 7) * 8); } \
        glp = ((const float*)(P.ws + WS_GL))[slot_]; } while (0)
#define U_ISSUE(ci_, dst_) do { if (active) { const bf16_t* gUC_ = (const bf16_t*)(P.ws + WS_UC) + (size_t)(sample ? 1024 + bh : bh * 32 + (ci_)) * 8192; \
        _Pragma("unroll") for (int mt_ = 0; mt_ < MT; ++mt_) dst_[mt_] = *(const u32x2*)(gUC_ + ((ct * 4 + mt_) * 64 + lane) * 4); } } while (0)
#define SCAN_STORE(par_) do { LAS bf16_t* W_ = (LAS bf16_t*)(lds + (par_) * BUF); LAS bf16_t* Q_ = (LAS bf16_t*)(lds + (par_) * BUF + 17408); \
        LAS bf16_t* A_ = (LAS bf16_t*)(lds + (par_) * BUF + 34816); LAS bf16_t* K_ = (LAS bf16_t*)(lds + (par_) * BUF + 44032); \
        _Pragma("unroll") for (int i_ = 0; i_ < NB3; ++i_) { const int idx_ = tid + 512 * i_, r_ = idx_ >> 4, c8_ = (idx_ & 15) * 8; \
            *(LAS u32x4*)(W_ + r_ * 136 + c8_) = pfW[i_]; *(LAS u32x4*)(Q_ + r_ * 136 + c8_) = pfQ[i_]; } \
        if (tid < C * 8) *(LAS u32x4*)(A_ + (tid >> 3) * 72 + (tid & 7) * 8) = pfA; \
        _Pragma("unroll") for (int i_ = 0; i_ < 2; ++i_) { const int idx_ = tid + 512 * i_; *(LAS u32x4*)(K_ + (idx_ >> 3) * 72 + (idx_ & 7) * 8) = pfK[i_]; } } while (0)
    u32x2 uc[MT], un[MT]; float gl, gln = 0.f;
#pragma unroll
    for (int mt = 0; mt < MT; ++mt) { uc[mt] = (u32x2){0u, 0u}; un[mt] = (u32x2){0u, 0u}; }
    SCAN_ISSUE(0);
    U_ISSUE(0, uc);
    SCAN_STORE(0);
    gl = glp;
    if (nch > 1) SCAN_ISSUE(1);
    __syncthreads();
    for (int ci = 0; ci < nch; ++ci) {
        const int par = ci & 1, row0 = sample ? TP + b * 32 : b * 2048 + ci * 64;
        if (ci + 1 < nch) {
            U_ISSUE(ci + 1, un);
            SCAN_STORE(par ^ 1);
            gln = glp;
            if (ci + 2 < nch) SCAN_ISSUE(ci + 2);
        }
        if (active) {
            const LAS bf16_t* WCs = (const LAS bf16_t*)(lds + par * BUF); const LAS bf16_t* QGs = (const LAS bf16_t*)(lds + par * BUF + 17408);
            const LAS bf16_t* ATs = (const LAS bf16_t*)(lds + par * BUF + 34816); const LAS bf16_t* KGs = (const LAS bf16_t*)(lds + par * BUF + 44032);
            bf16x8 Sb[4];
#pragma unroll
            for (int s = 0; s < 4; ++s) Sb[s] = packB(S[2 * s], S[2 * s + 1]);
            f32x4 vn[MT], oa[MT];
#pragma unroll
            for (int mt = 0; mt < MT; ++mt) { oa[mt] = (f32x4){0.f, 0.f, 0.f, 0.f};
                vn[mt] = (f32x4){-bflo(uc[mt].x), -bfhi(uc[mt].x), -bflo(uc[mt].y), -bfhi(uc[mt].y)}; }
            bf16x8 f0[4], f1[4];
#define SCAN_SB() __builtin_amdgcn_sched_barrier(0)
#define LD_ROWS(dst, X, ld, s_) _Pragma("unroll") for (int mt = 0; mt < MT; ++mt) dst[mt] = ldA(X, ld, 16 * mt + m, (s_), kq);
#define LD_KT(dst, s_, k0_) _Pragma("unroll") for (int kt = 0; kt < 4; ++kt) dst[kt] = ldA(KGs, 72, 16 * ((k0_) + kt) + m, (s_), kq);
#define MM_ROWS(acc, src, bop) _Pragma("unroll") for (int mt = 0; mt < MT; ++mt) acc[mt] = MFMA16(src[mt], (bop), acc[mt]);
#define MM_KT(src, bop, k0_) _Pragma("unroll") for (int kt = 0; kt < 4; ++kt) S[(k0_) + kt] = MFMA16(src[kt], (bop), S[(k0_) + kt]);
            LD_ROWS(f0, WCs, 136, 0); LD_ROWS(f1, WCs, 136, 1); SCAN_SB();
            MM_ROWS(vn, f0, Sb[0]); LD_ROWS(f0, WCs, 136, 2); SCAN_SB();
            MM_ROWS(vn, f1, Sb[1]); LD_ROWS(f1, WCs, 136, 3); SCAN_SB();
            MM_ROWS(vn, f0, Sb[2]); LD_ROWS(f0, QGs, 136, 0); SCAN_SB();
            MM_ROWS(vn, f1, Sb[3]); LD_ROWS(f1, QGs, 136, 1); SCAN_SB();
            MM_ROWS(oa, f0, Sb[0]); LD_ROWS(f0, QGs, 136, 2); SCAN_SB();
            MM_ROWS(oa, f1, Sb[1]); LD_ROWS(f1, QGs, 136, 3); SCAN_SB();
            MM_ROWS(oa, f0, Sb[2]); LD_ROWS(f0, ATs, 72, 0); SCAN_SB();
            MM_ROWS(oa, f1, Sb[3]);
#pragma unroll
            for (int mt = 0; mt < MT; ++mt)
#pragma unroll
                for (int r = 0; r < 4; ++r) vn[mt][r] = -vn[mt][r];
            bf16x8 Vb[KS];
#pragma unroll
            for (int s = 0; s < KS; ++s) Vb[s] = packB(vn[2 * s], vn[2 * s + 1]);
#pragma unroll
            for (int kt = 0; kt < 8; ++kt) S[kt] = S[kt] * gl;
            if (KS == 2) {
                LD_ROWS(f1, ATs, 72, KS - 1); SCAN_SB();
                MM_ROWS(oa, f0, Vb[0]); LD_KT(f0, 0, 0); SCAN_SB();
                MM_ROWS(oa, f1, Vb[KS - 1]); LD_KT(f1, 0, 4); SCAN_SB();
                MM_KT(f0, Vb[0], 0); LD_KT(f0, KS - 1, 0); SCAN_SB();
                MM_KT(f1, Vb[0], 4); LD_KT(f1, KS - 1, 4); SCAN_SB();
                MM_KT(f0, Vb[KS - 1], 0); SCAN_SB();
                MM_KT(f1, Vb[KS - 1], 4);
            } else {
                LD_KT(f1, 0, 0); SCAN_SB();
                MM_ROWS(oa, f0, Vb[0]); LD_KT(f0, 0, 4); SCAN_SB();
                MM_KT(f1, Vb[0], 0); SCAN_SB();
                MM_KT(f0, Vb[0], 4);
            }
            { bf16_t* op = mixcat + (size_t)(row0 + kq * 4) * 1024 + 512 + h * 128 + vcol;
#pragma unroll
              for (int mt = 0; mt < MT; ++mt) {
#pragma unroll
                for (int r = 0; r < 4; ++r) { *op = f2bf(oa[mt][r]); op += 1024; asm volatile("" : "+v"(op)); }
                op += 12 * 1024; asm volatile("" : "+v"(op)); } }
#undef LD_ROWS
#undef LD_KT
#undef MM_KT
#undef MM_ROWS
#undef SCAN_SB
        }
        __syncthreads();
#pragma unroll
        for (int mt = 0; mt < MT; ++mt) uc[mt] = un[mt];
        gl = gln;
    }
#undef SCAN_ISSUE
#undef SCAN_STORE
#undef U_ISSUE
    if (active) { float* od = P.out + (sample ? O_SDELTA : O_PDELTA) + ((size_t)(l * 8 + b) * 4 + h) * 16384;
#pragma unroll
        for (int kt = 0; kt < 8; ++kt)
#pragma unroll
            for (int r = 0; r < 4; ++r) od[(16 * kt + kq * 4 + r) * 128 + vcol] = S[kt][r]; }
    __syncthreads();
}
__device__ __forceinline__ void phase_gnorm(const Params& P, int l) {
    const int tid = tid_l(), lane = tid & 63, wave = tid >> 6;
    bf16_t* mixcat = (bf16_t*)(P.ws + WS_ACT); const bf16_t* p = (const bf16_t*)(P.ws + WS_A);
    const float* gn = P.in[17] + l * 128 + (lane & 15) * 8;
    const f32x4 g0 = *(const f32x4*)gn, g1 = *(const f32x4*)(gn + 4);
    const int rstride = gridDim.x * 8; int r = bid_l() * 8 + wave;
    u32x4 ov, zv;
    if (r < TT) { ov = *(const u32x4*)(mixcat + (size_t)r * 1024 + 512 + lane * 8); zv = *(const u32x4*)(p + (size_t)r * 3072 + 2560 + lane * 8); }
    for (; r < TT; r += rstride) {
        u32x4 on, zn; const int rn_ = r + rstride;
        if (rn_ < TT) { on = *(const u32x4*)(mixcat + (size_t)rn_ * 1024 + 512 + lane * 8); zn = *(const u32x4*)(p + (size_t)rn_ * 3072 + 2560 + lane * 8); }
        float o[8], z[8]; float ss = 0.f;
#pragma unroll
        for (int e = 0; e < 4; ++e) { o[2 * e] = bflo(ov[e]); o[2 * e + 1] = bfhi(ov[e]); z[2 * e] = bflo(zv[e]); z[2 * e + 1] = bfhi(zv[e]); }
#pragma unroll
        for (int e = 0; e < 8; ++e) ss += o[e] * o[e];
        ss += __shfl_xor(ss, 1); ss += __shfl_xor(ss, 2); ss += __shfl_xor(ss, 4); ss += __shfl_xor(ss, 8);
        const float rstd = rsqrtf(ss * (1.f / 128.f) + 1e-6f);
        u32x4 w; w.x = pk2(o[0] * rstd * g0[0] * z[0], o[1] * rstd * g0[1] * z[1]); w.y = pk2(o[2] * rstd * g0[2] * z[2], o[3] * rstd * g0[3] * z[3]);
        w.z = pk2(o[4] * rstd * g1[0] * z[4], o[5] * rstd * g1[1] * z[5]); w.w = pk2(o[6] * rstd * g1[2] * z[6], o[7] * rstd * g1[3] * z[7]);
        *(u32x4*)(mixcat + (size_t)r * 1024 + 512 + lane * 8) = w;
        ov = on; zv = zn;
    }
}

template <int PC> __device__ __forceinline__ void sgu_item(const Params& P, int l, int b, int row0, bool sample, int g0, int g1, LAS unsigned char* lds) {
    constexpr int LDV = PC + 8, KS = PC / 32;
#define SGU_SWZ(c_) ((((c_) >> 3) & (PC / 8 - 1)) << 3)
    const int tid = tid_l(), lane = tid & 63, wave = tid >> 6, m = lane & 15, kq = lane >> 4;
    LAS bf16_t* vT = (LAS bf16_t*)lds;
    LAS float* rstd = (LAS float*)(lds + 128 * LDV * 2);
    const bf16_t* p = (const bf16_t*)(P.ws + WS_A); bf16_t* mixcat = (bf16_t*)(P.ws + WS_ACT);
    { u32x4 rw[PC / 8];
#pragma unroll
        for (int i = 0; i < PC / 8; ++i) rw[i] = *(const u32x4*)(p + (size_t)(row0 + wave + 8 * i) * 3072 + 512 + lane * 8);
#pragma unroll
        for (int i = 0; i < PC / 8; ++i) { float ss = 0.f;
#pragma unroll
            for (int e = 0; e < 4; ++e) { const float a = bflo(rw[i][e]), c = bfhi(rw[i][e]); ss += a * a + c * c; }
            ss = wave_sum(ss); if (lane == 0) rstd[wave + 8 * i] = rsqrtf(ss * (1.f / 512.f) + 1e-6f); } }
    __syncthreads();
    for (int g = g0; g < g1; ++g) {
        const float* gam = P.in[11] + l * 512 + g * 128;
        constexpr int NBV = PC / 32;
        u32x4 rv[NBV];
#pragma unroll
        for (int i = 0; i < NBV; ++i) { const int idx = tid + 512 * i, q = idx >> 4, c8 = (idx & 15) * 8; rv[i] = *(const u32x4*)(p + (size_t)(row0 + q) * 3072 + 512 + g * 128 + c8); }
#pragma unroll
        for (int i = 0; i < NBV; ++i) { const int idx = tid + 512 * i, q = idx >> 4, c8 = (idx & 15) * 8; const u32x4 raw = rv[i]; const float rs = rstd[q];
#pragma unroll
            for (int e = 0; e < 8; ++e) { const float x = (e & 1) ? bfhi(raw[e >> 1]) : bflo(raw[e >> 1]); const float vn = x * rs * gam[c8 + e];
                vT[(c8 + e) * LDV + (q ^ SGU_SWZ(c8))] = f2bf(vn);
                if (sample) P.out[O_SGUV + ((size_t)(l * 8 + b) * 32 + q) * 512 + g * 128 + c8 + e] = vn; } }
        __syncthreads();
        int pt, ct0, nks;
        if (PC == 128) { pt = wave; ct0 = 0; nks = (pt < 4) ? 2 : 4; } else { pt = wave & 1; ct0 = (wave >> 1) * 2; nks = 1; }
        const int prow = 16 * pt + m; const float* wrow = P.in[12] + ((size_t)(l * 4 + g) * 128 + prow) * 128;
        bf16x8 Wf[KS];
#pragma unroll
        for (int s = 0; s < KS; ++s) { if (s < nks) { const f32x4 a = *(const f32x4*)(wrow + 32 * s + kq * 8), c = *(const f32x4*)(wrow + 32 * s + kq * 8 + 4);
                Wf[s] = mk8(pk2(a[0], a[1]), pk2(a[2], a[3]), pk2(c[0], c[1]), pk2(c[2], c[3])); } else Wf[s] = mk8(0u, 0u, 0u, 0u); }
        const float bias = P.in[13][(l * 4 + g) * 128 + prow];
        const size_t row = (size_t)(row0 + prow);
        constexpr int NCT = PC == 128 ? 8 : 2;
        u32x2 urv[NCT];
#pragma unroll
        for (int i = 0; i < NCT; ++i) urv[i] = *(const u32x2*)(p + row * 3072 + g * 128 + 16 * (ct0 + i) + kq * 4);
#pragma unroll
        for (int i = 0; i < NCT; ++i) { const int ct = ct0 + i; f32x4 acc = {0.f, 0.f, 0.f, 0.f};
#pragma unroll
            for (int s = 0; s < KS; ++s) if (s < nks) acc = MFMA16(*(const LAS bf16x8*)(vT + (16 * ct + m) * LDV + ((32 * s + kq * 8) ^ SGU_SWZ(16 * ct + m))), Wf[s], acc);
            const int ch = g * 128 + 16 * ct + kq * 4;
            const u32x2 ur = urv[i];
            u32x2 w; w.x = pk2(bflo(ur.x) * (acc[0] + bias), bfhi(ur.x) * (acc[1] + bias)); w.y = pk2(bflo(ur.y) * (acc[2] + bias), bfhi(ur.y) * (acc[3] + bias));
            *(u32x2*)(mixcat + row * 1024 + ch) = w; }
        __syncthreads();
    }
}
__device__ __forceinline__ void phase_scan_sgu(const Params& P, int l, LAS unsigned char* lds) {
    const int bid = bid_l(); const bool isScan = bid < 128; const int j = bid - 128;
    if (isScan) scan_job<64>(P, l, (bid & 7) + 8 * (bid >> 5), (bid >> 3) & 3, false, lds);
    else scan_job<32>(P, l, (j & 7) + 8 * (j >> 5), (j >> 3) & 3, true, lds);
    const int nq = isScan ? 1 : 3;
    for (int k = 0; k < nq; ++k) { const int qi = isScan ? 384 + bid : j + 128 * k; const int it = qi >> 2, g = qi & 3, b = it >> 4, n = it & 15;
        sgu_item<128>(P, l, b, b * 2048 + n * 128, false, g, g + 1, lds); }
    if (!isScan && j < 8) sgu_item<32>(P, l, j, TP + j * 32, true, 0, 4, lds);
}

#define XB_TMO      128
#define XB_XCNT(j)  (256  + 64 * (j))
#define XB_XSUB(j)  (1280 + 64 * (j))
#define XB_XGEN(j)  (2304 + 64 * (j))
#define XB_TOP      3328
#define XB_TOPGEN   3392
#define XCD_BAR_WORDS 3456
#define XB_SPIN_CAP (1u << 18)

__device__ __forceinline__ unsigned xb_ld(unsigned* p)              { return __hip_atomic_load(p, __ATOMIC_RELAXED, __HIP_MEMORY_SCOPE_AGENT); }
__device__ __forceinline__ unsigned xb_add(unsigned* p, unsigned v) { return __hip_atomic_fetch_add(p, v, __ATOMIC_RELAXED, __HIP_MEMORY_SCOPE_AGENT); }
__device__ __forceinline__ unsigned xb_xcc_id() { return (unsigned)__builtin_amdgcn_s_getreg((3 << 11) | 20) & 0xFu; }
#define XB_SPIN(cond, bar) do { unsigned _sp = 0; while (cond) { __builtin_amdgcn_s_sleep(1); \
    if ((++_sp & 255u) == 0u) { if (xb_ld(&(bar)[XB_TMO])) break; if (_sp > XB_SPIN_CAP) { atomicAdd(&(bar)[XB_TMO], 1u); break; } } } } while (0)

struct XcdBarrier {
    unsigned* bar; unsigned x;
    volatile LAS unsigned* st;
};

__device__ __forceinline__ XcdBarrier xcd_barrier_post(unsigned* bar, volatile LAS unsigned* st) {
    XcdBarrier b; b.bar = bar; b.x = xb_xcc_id(); b.st = st;
    if (threadIdx.x == 0) (void)xb_add(&bar[XB_XCNT(b.x)], 1u);
    return b;
}
__device__ __forceinline__ void xcd_barrier_complete(unsigned* bar, unsigned x, unsigned& nloc, unsigned& nx) {
    const unsigned G = gridDim.x * gridDim.y * gridDim.z;
    unsigned sum, cnt, mine, sp = 0u;
    for (;;) {
        sum = 0u; cnt = 0u; mine = 0u;
#pragma unroll
        for (unsigned j = 0; j < 16; ++j) { const unsigned c = xb_ld(&bar[XB_XCNT(j)]); sum += c; cnt += (c > 0u) ? 1u : 0u; mine = (j == x) ? c : mine; }
        if (sum == G) break;
        __builtin_amdgcn_s_sleep(1);
        if ((++sp & 255u) == 0u) { if (xb_ld(&bar[XB_TMO])) break; if (sp > XB_SPIN_CAP) { atomicAdd(&bar[XB_TMO], 1u); break; } }
    }
    nloc = mine > 0u ? mine : 1u; nx = cnt > 0u ? cnt : 1u;
}

__device__ __forceinline__ void xcd_barrier(const XcdBarrier& b) {
    asm volatile("s_waitcnt vmcnt(0)" ::: "memory");
    __syncthreads();
    if (threadIdx.x == 0) {
        unsigned* bar = b.bar;
        __builtin_amdgcn_s_waitcnt(0);
        unsigned nloc = b.st[0], nx = b.st[1];
        if (nloc == 0u) { xcd_barrier_complete(bar, b.x, nloc, nx); b.st[0] = nloc; b.st[1] = nx; }
        const unsigned old = xb_add(&bar[XB_XSUB(b.x)], 1u);
        const unsigned gen = old / nloc;
        if (old + 1u == (gen + 1u) * nloc) {
            __builtin_amdgcn_fence(__ATOMIC_RELEASE, "agent");
            asm volatile("s_waitcnt vmcnt(0)" ::: "memory");
            const unsigned og = xb_add(&bar[XB_TOP], 1u);
            const unsigned tg = og / nx;
            if (og + 1u == (tg + 1u) * nx) xb_add(&bar[XB_TOPGEN], 1u);
            else XB_SPIN(xb_ld(&bar[XB_TOPGEN]) == tg, bar);
            __builtin_amdgcn_fence(__ATOMIC_ACQUIRE, "agent");
            xb_add(&bar[XB_XGEN(b.x)], 1u);
            asm volatile("s_waitcnt vmcnt(0)" ::: "memory");
        } else {
            XB_SPIN(xb_ld(&bar[XB_XGEN(b.x)]) == gen, bar);
            __builtin_amdgcn_fence(__ATOMIC_ACQUIRE, "agent");
            asm volatile("s_waitcnt vmcnt(0)" ::: "memory");
        }
    }
    __syncthreads();
}

__device__ __forceinline__ void phase_final(const Params& P, const XcdBarrier& bar) {
    const int tid = tid_l(), lane = tid & 63, wave = tid >> 6, gw = bid_l() * 8 + wave;
    const bf16_t* xb = xb_ptr(P);
    constexpr int HALF_ROWS = TT / 2;
    f32x4 g4[4];
#pragma unroll
    for (int i = 0; i < 4; ++i) g4[i] = *(const f32x4*)(P.in[21] + lane * 4 + 256 * i);
    u32x2 up[5][4];
#pragma unroll
    for (int k = 0; k < 5; ++k) { const int r = HALF_ROWS + gw + 2048 * k;
#pragma unroll
        for (int i = 0; i < 4; ++i) up[k][i] = r < TT ? *(const u32x2*)(xb + (size_t)r * 1024 + lane * 4 + 256 * i) : (u32x2){0u, 0u}; }
    for (int r = gw; r < HALF_ROWS; r += 2048) { f32x4 v[4]; float ss = 0.f;
#pragma unroll
        for (int i = 0; i < 4; ++i) { v[i] = bf4(*(const u32x2*)(xb + (size_t)r * 1024 + lane * 4 + 256 * i)); ss += v[i][0] * v[i][0] + v[i][1] * v[i][1] + v[i][2] * v[i][2] + v[i][3] * v[i][3]; }
        ss = wave_sum(ss); const float rstd = rsqrtf(ss * (1.f / 1024.f) + 1e-6f);
#pragma unroll
        for (int i = 0; i < 4; ++i) *(f32x4*)(P.out + (size_t)r * 1024 + lane * 4 + 256 * i) = v[i] * rstd * g4[i]; }
    xcd_barrier(bar);
#pragma unroll
    for (int k = 0; k < 5; ++k) { const int r = HALF_ROWS + gw + 2048 * k;
        if (r < TT) { f32x4 v[4]; float ss = 0.f;
#pragma unroll
            for (int i = 0; i < 4; ++i) { v[i] = bf4(up[k][i]); ss += v[i][0] * v[i][0] + v[i][1] * v[i][1] + v[i][2] * v[i][2] + v[i][3] * v[i][3]; }
            ss = wave_sum(ss); const float rstd = rsqrtf(ss * (1.f / 1024.f) + 1e-6f);
#pragma unroll
            for (int i = 0; i < 4; ++i) *(f32x4*)(P.out + (size_t)r * 1024 + lane * 4 + 256 * i) = v[i] * rstd * g4[i]; } }
}

constexpr int N_PHASES = 20;
__global__ void __launch_bounds__(512, 2) mega(Params P) {
    extern __shared__ __attribute__((aligned(16))) unsigned char lds_raw[];
    LAS unsigned char* lds = (LAS unsigned char*)lds_raw;
    cg::grid_group grid = cg::this_grid();
    unsigned* barw = (unsigned*)(P.ws + WS_BAR);
    volatile LAS unsigned* bst = (volatile LAS unsigned*)(lds + 155648);
    if (threadIdx.x < 2) bst[threadIdx.x] = 0u;
    __syncthreads();
    XcdBarrier bar = xcd_barrier_post(barw, bst);
    if (P.ph_hi > 1000) grid.sync();
    int ph = 0;
#ifndef PROBE_KIND
#define PROBE_KIND -1
#endif
#define PHASE(kind, ...) do { if (ph >= P.ph_lo && ph < P.ph_hi) { int nrep_ = ((kind) == PROBE_KIND) ? 2 : 1; asm volatile("" : "+s"(nrep_)); \
        for (int rep_ = 0; rep_ < nrep_; ++rep_) { __VA_ARGS__; if (rep_ + 1 < nrep_) __syncthreads(); } \
        if (ph + 1 < P.ph_hi) xcd_barrier(bar); } ++ph; } while (0)
    PHASE(0, phase0(P, lds));
#pragma unroll 1
    for (int l = 0; l < 2; ++l) {
        const unsigned char* wl = P.ws + (size_t)l * W_LAYER;
        const float* modl = (const float*)(P.ws + WS_MOD) + (size_t)l * 16 * 6144;
        PHASE(1, phase_h<true>(P, l, lds));
        PHASE(2, { EpiP e; e.O = (bf16_t*)(P.ws + WS_A); run_gemm<true>(lds, (const bf16_t*)(P.ws + WS_B), (const bf16_t*)(wl + W_IN), 3072, 1024, e);
                small_gemm<64, 64, 4>(lds, (const bf16_t*)(P.ws + WS_B), (const bf16_t*)(wl + W_IN), 3072, 1024, e); });
        PHASE(3, phase_b1(P, l, lds));
        PHASE(4, phase_scan_sgu(P, l, lds));
        PHASE(10, phase_gnorm(P, l));
        PHASE(5, { EpiRes e; e.base_p = P.in[0]; e.base_s = P.in[1]; e.xb = xb_ptr(P); e.basef32 = l == 0; e.gate = modl + 2048;
                run_gemm<false>(lds, (const bf16_t*)(P.ws + WS_ACT), (const bf16_t*)(wl + W_OUT), 1024, 1024, e);
                small_gemm<32, 32, 4>(lds, (const bf16_t*)(P.ws + WS_ACT), (const bf16_t*)(wl + W_OUT), 1024, 1024, e); });
        PHASE(6, phase_h<false>(P, l, lds));
        PHASE(7, { EpiH e; e.O = (bf16_t*)(P.ws + WS_A); run_gemm<true>(lds, (const bf16_t*)(P.ws + WS_B), (const bf16_t*)(wl + W_UP), 4096, 1024, e);
                small_gemm<64, 64, 4>(lds, (const bf16_t*)(P.ws + WS_B), (const bf16_t*)(wl + W_UP), 4096, 1024, e); });
        PHASE(8, { EpiRes e; e.base_p = P.in[0]; e.base_s = P.in[1]; e.xb = xb_ptr(P); e.basef32 = 0; e.gate = modl + 5120;
                run_gemm<false>(lds, (const bf16_t*)(P.ws + WS_A), (const bf16_t*)(wl + W_DOWN), 1024, 4096, e);
                small_gemm<32, 32, 8>(lds, (const bf16_t*)(P.ws + WS_A), (const bf16_t*)(wl + W_DOWN), 1024, 4096, e); });
    }
    PHASE(9, phase_final(P, bar));
#undef PHASE
}

#ifndef MK_PER_PHASE
#define MK_PER_PHASE 0
#endif
extern "C" void kernel_launch(void* const* d_in, const int* in_sizes, int n_in, void* d_out, int out_size, void* d_ws, size_t ws_size, hipStream_t stream) {
    static int grid = 0;
    if (grid == 0) {
        if (n_in != 22 || (size_t)out_size != O_END || ws_size < WS_END) { fprintf(stderr, "kernel_launch: unexpected shapes: n_in %d out %d ws %zu (need %zu)\n", n_in, out_size, ws_size, (size_t)WS_END); grid = -1; return; }
        int dev = 0, cus = 0, per_cu = 0;
        if (hipGetDevice(&dev) != hipSuccess || hipDeviceGetAttribute(&cus, hipDeviceAttributeMultiprocessorCount, dev) != hipSuccess) { grid = -1; return; }
        if (hipFuncSetAttribute((const void*)mega, hipFuncAttributeMaxDynamicSharedMemorySize, LDS_BYTES) != hipSuccess) { fprintf(stderr, "kernel_launch: hipFuncSetAttribute failed\n"); grid = -1; return; }
        if (hipOccupancyMaxActiveBlocksPerMultiprocessor(&per_cu, (const void*)mega, 512, LDS_BYTES) != hipSuccess || per_cu < 1) { fprintf(stderr, "kernel_launch: occupancy query says %d\n", per_cu); (void)hipGetLastError(); grid = -1; return; }
        if (cus < 256) { fprintf(stderr, "kernel_launch: needs 256 CUs, device has %d\n", cus); grid = -1; return; }
        grid = 256;
    }
    if (grid < 0) return;
    Params p{};
    for (int i = 0; i < 22; ++i) p.in[i] = (const float*)d_in[i];
    p.out = (float*)d_out; p.ws = (unsigned char*)d_ws;
#if MK_PER_PHASE
    for (int ph = 0; ph < N_PHASES; ++ph) { p.ph_lo = ph; p.ph_hi = ph + 1; hipLaunchKernelGGL(mega, dim3(grid), dim3(512), LDS_BYTES, stream, p); }
#else
    p.ph_lo = 0; p.ph_hi = N_PHASES;
    if (hipMemsetAsync((char*)d_ws + WS_BAR, 0, 3456 * 4, stream) != hipSuccess) { fprintf(stderr, "kernel_launch: memset of the barrier words failed\n"); return; }
    void* args[] = {&p};
    const hipError_t e = hipLaunchCooperativeKernel((const void*)mega, dim3(grid), dim3(512), args, LDS_BYTES, stream);
    if (e != hipSuccess) fprintf(stderr, "kernel_launch: cooperative launch failed: %s (grid %d)\n", hipGetErrorString(e), grid);
#endif
}
```

```cpp
#include <hip/hip_runtime.h>
#include <hip/hip_cooperative_groups.h>
#include <cstdio>
#include <cstdint>
namespace cg = cooperative_groups;
namespace pg8 {
#define PG8_LAS __attribute__((address_space(3)))
typedef unsigned short bf16_t;
typedef short bf16x8 __attribute__((ext_vector_type(8)));
typedef float f32x4 __attribute__((ext_vector_type(4)));
typedef unsigned u32x4 __attribute__((ext_vector_type(4)));
constexpr int BM = 256, BK = 64, HALF = 128, HTB = HALF * BK * 2  , STAGE_BYTES = 8 * HTB, NXCD = 8, WGM = 8;

__host__ __device__ __forceinline__ int lds_byte(int r, int c) { const int st = (r >> 4) * 2 + (c >> 5), rr = r & 15, cc = c & 31, ob = rr * 64 + cc * 2; return st * 1024 + (ob ^ (((ob >> 9) & 1) << 5)); }
__host__ __device__ __forceinline__ void stage_rc(int b, int& R, int& C) { const int st = b / 1024, sb = b % 1024, swz = sb ^ (((sb >> 9) & 1) << 5); R = (st >> 1) * 16 + swz / 64; C = (st & 1) * 32 + (swz % 64) / 2; }
__host__ __device__ __forceinline__ int perm32(int rho) { const int n = rho >> 4, i = rho & 15; return 8 * (i >> 2) + 4 * n + (i & 3); }

struct Unit { int pm, pn; };
struct Gemm { const bf16_t* A; const bf16_t* Bt; int M, N, K; };

struct StaticOrder {
    int nM, nN, nwg, G, c;
    __host__ __device__ void init(int M, int N, int G_, int c_) { nM = M / BM; nN = N / BM; nwg = nM * nN; G = G_; c = c_; }
    __host__ __device__ bool next(int i, Unit& u) const {
        const long L = (long)i * G + c; if (L >= nwg) return false;
        int wgid = (int)L; { const int q = nwg / NXCD, r = nwg % NXCD, xcd = wgid % NXCD, off = wgid / NXCD; wgid = (xcd < r ? xcd * (q + 1) : r * (q + 1) + (xcd - r) * q) + off; }
        const int nig = WGM * nN, gid = wgid / nig, fm = gid * WGM, gsz = (nM - fm) < WGM ? (nM - fm) : WGM;
        u.pm = fm + ((wgid % nig) % gsz); u.pn = (wgid % nig) / gsz; return true;
    }
    __device__ __forceinline__ void a_ready(const Unit&) const {}
    __device__ __forceinline__ void done(const Unit&) const {}
};
__device__ __forceinline__ unsigned cvt_pk_bf16(float lo, float hi) { unsigned r; asm volatile("v_cvt_pk_bf16_f32 %0, %1, %2" : "=v"(r) : "v"(lo), "v"(hi)); return r; }
typedef float f32x2 __attribute__((ext_vector_type(2)));
template <class Epi, class Sched, bool ALIGN_EPI = false, bool SP2 = false>
__device__ __forceinline__ void gemm_phase(PG8_LAS unsigned char* lds, const Gemm g, const Sched& S, const Epi& E) {
    int tid_ = threadIdx.x; asm volatile("" : "+v"(tid_));
    const int tid = tid_, wid = __builtin_amdgcn_readfirstlane(tid >> 6), lane = tid & 63, wr = wid >> 2, wc = wid & 3, fr = lane & 15, fq = lane >> 4;
    const int K = g.K, nt = K / BK;
    unsigned voffA[2], voffB[2];
#pragma unroll
    for (int i = 0; i < 2; ++i) { int R, C; stage_rc(tid * 16 + i * 8192, R, C); const int Rb = Epi::PERM ? ((R & ~31) + perm32(R & 31)) : R;
        voffA[i] = (unsigned)(R * K + C) * 2u; voffB[i] = (unsigned)(Rb * K + C) * 2u; }
    const size_t kstep = (size_t)(BK * 2);
    const size_t hstep = (size_t)HALF * K * 2;
    const size_t tstep = 2 * hstep;
    const unsigned ldsw = (unsigned)wid * 1024u;
    const int aoff = lds_byte(wr * 64 + fr, fq * 8), boff = lds_byte(wc * 32 + fr, fq * 8);
#define PG8_SA(b, h) (((b) * 2 + (h)) * HTB)
#define PG8_SB(b, h) ((4 + (b) * 2 + (h)) * HTB)
#define PG8_STAGE(bufoff, gbase, voff) do { _Pragma("unroll") for (int _i = 0; _i < 2; ++_i) \
        __builtin_amdgcn_global_load_lds((const unsigned*)((const char*)(gbase) + (voff)[_i]), (PG8_LAS unsigned*)(lds + (bufoff) + ldsw + _i * 8192), 16, 0, 0); } while (0)
#define PG8_LDA(dst, b, h) do { _Pragma("unroll") for (int m = 0; m < 4; ++m) _Pragma("unroll") for (int k = 0; k < 2; ++k) dst[m][k] = *(const PG8_LAS bf16x8*)(lds + PG8_SA(b, h) + aoff + m * 2048 + k * 1024); } while (0)
#define PG8_LDB(dst, b, h) do { _Pragma("unroll") for (int n = 0; n < 2; ++n) _Pragma("unroll") for (int k = 0; k < 2; ++k) dst[n][k] = *(const PG8_LAS bf16x8*)(lds + PG8_SB(b, h) + boff + n * 2048 + k * 1024); } while (0)
#define PG8_MMA(ai, bj, At, Bt) do { __builtin_amdgcn_s_setprio(1); _Pragma("unroll") for (int m = 0; m < 4; ++m) _Pragma("unroll") for (int n = 0; n < 2; ++n) _Pragma("unroll") for (int k = 0; k < 2; ++k) \
        acc[ai][bj][m][n] = __builtin_amdgcn_mfma_f32_16x16x32_bf16(Bt[n][k], At[m][k], acc[ai][bj][m][n], 0, 0, 0); __builtin_amdgcn_s_setprio(0); } while (0)
#define PG8_WAIT_V(n) asm volatile("s_waitcnt vmcnt(" #n ")" ::: "memory")
#define PG8_WAIT_L(n) asm volatile("s_waitcnt lgkmcnt(" #n ")" ::: "memory")
#define PG8_BAR __builtin_amdgcn_s_barrier()
#define PG8_SCHED __builtin_amdgcn_sched_barrier(0)
    Unit cur, nxt; int ui = 0;
    if (!S.next(0, cur)) return;
    f32x4 acc[2][2][4][2];
#pragma unroll
    for (int a = 0; a < 2; ++a)
#pragma unroll
        for (int b = 0; b < 2; ++b)
#pragma unroll
            for (int m = 0; m < 4; ++m)
#pragma unroll
                for (int n = 0; n < 2; ++n) acc[a][b][m][n] = (f32x4){0.f, 0.f, 0.f, 0.f};
    bf16x8 At[4][2], B0[2][2], B1[2][2];
    const char* cA = (const char*)g.A + (size_t)cur.pm * tstep; const char* cB = (const char*)g.Bt + (size_t)cur.pn * tstep;
    S.a_ready(cur);
    if constexpr (SP2) {
        PG8_STAGE(PG8_SB(0, 0), cB, voffB); PG8_STAGE(PG8_SB(0, 1), cB + hstep, voffB); PG8_STAGE(PG8_SA(0, 0), cA, voffA); PG8_STAGE(PG8_SA(0, 1), cA + hstep, voffA);
        if (wr == 1) PG8_BAR;
        PG8_WAIT_V(2); PG8_BAR;
        PG8_STAGE(PG8_SB(1, 0), cB + kstep, voffB); PG8_STAGE(PG8_SA(1, 0), cA + kstep, voffA); PG8_STAGE(PG8_SB(1, 1), cB + hstep + kstep, voffB);
        PG8_WAIT_V(6); PG8_BAR;
    } else {
        PG8_STAGE(PG8_SB(0, 0), cB, voffB); PG8_STAGE(PG8_SA(0, 0), cA, voffA); PG8_STAGE(PG8_SB(0, 1), cB + hstep, voffB); PG8_STAGE(PG8_SA(0, 1), cA + hstep, voffA);
        if (wr == 1) PG8_BAR;
        PG8_WAIT_V(4); PG8_BAR;
        PG8_STAGE(PG8_SB(1, 0), cB + kstep, voffB); PG8_STAGE(PG8_SA(1, 0), cA + kstep, voffA); PG8_STAGE(PG8_SB(1, 1), cB + hstep + kstep, voffB);
        PG8_WAIT_V(6); PG8_BAR;
    }
    for (;;) {
        const bool has_next = S.next(ui + 1, nxt);
        const char* nA = has_next ? (const char*)g.A + (size_t)nxt.pm * tstep : cA; const char* nB = has_next ? (const char*)g.Bt + (size_t)nxt.pn * tstep : cB;
        for (int t = 0; t < nt; t += 2) {
            const bool last = (t == nt - 2);
            const char* a1 = cA + (size_t)(t + 1) * kstep;
            const char* a2 = last ? nA : cA + (size_t)(t + 2) * kstep; const char* b2 = last ? nB : cB + (size_t)(t + 2) * kstep;
            const char* a3 = a2 + kstep; const char* b3 = b2 + kstep;
            if (last && has_next) S.a_ready(nxt);
            if constexpr (SP2) {
            PG8_LDB(B0, 0, 0); PG8_LDB(B1, 0, 1); PG8_SCHED; PG8_LDA(At, 0, 0); PG8_STAGE(PG8_SA(1, 1), a1 + hstep, voffA);
            PG8_WAIT_V(8); PG8_WAIT_L(0); PG8_BAR; PG8_MMA(0, 0, At, B0); PG8_MMA(0, 1, At, B1); PG8_BAR; PG8_SCHED;
            PG8_LDA(At, 0, 1); PG8_STAGE(PG8_SB(0, 0), b2, voffB); PG8_STAGE(PG8_SB(0, 1), b2 + hstep, voffB); PG8_STAGE(PG8_SA(0, 0), a2, voffA);
            PG8_WAIT_V(8); PG8_WAIT_L(0); PG8_BAR; PG8_MMA(1, 0, At, B0); PG8_MMA(1, 1, At, B1); PG8_BAR; PG8_SCHED;
            PG8_LDB(B0, 1, 0); PG8_LDB(B1, 1, 1); PG8_SCHED; PG8_LDA(At, 1, 0); PG8_STAGE(PG8_SA(0, 1), a2 + hstep, voffA);
            PG8_WAIT_V(8); PG8_WAIT_L(0); PG8_BAR; PG8_MMA(0, 0, At, B0); PG8_MMA(0, 1, At, B1); PG8_BAR; PG8_SCHED;
            PG8_LDA(At, 1, 1); PG8_STAGE(PG8_SB(1, 0), b3, voffB); PG8_STAGE(PG8_SB(1, 1), b3 + hstep, voffB); PG8_STAGE(PG8_SA(1, 0), a3, voffA);
            PG8_WAIT_V(8); PG8_WAIT_L(0); PG8_BAR; PG8_MMA(1, 0, At, B0); PG8_MMA(1, 1, At, B1); PG8_BAR; PG8_SCHED;
            } else {
            PG8_LDB(B0, 0, 0); PG8_SCHED; PG8_LDA(At, 0, 0); PG8_STAGE(PG8_SA(1, 1), a1 + hstep, voffA);
            PG8_WAIT_L(8); PG8_BAR; PG8_WAIT_L(0); PG8_MMA(0, 0, At, B0); PG8_BAR; PG8_SCHED;
            PG8_LDB(B1, 0, 1); PG8_STAGE(PG8_SB(0, 0), b2, voffB);
            PG8_BAR; PG8_WAIT_L(0); PG8_MMA(0, 1, At, B1); PG8_BAR;
            PG8_LDA(At, 0, 1); PG8_STAGE(PG8_SA(0, 0), a2, voffA);
            PG8_BAR; PG8_WAIT_L(0); PG8_MMA(1, 0, At, B0); PG8_BAR; PG8_SCHED;
            PG8_STAGE(PG8_SB(0, 1), b2 + hstep, voffB);
            PG8_WAIT_V(6); PG8_BAR; PG8_MMA(1, 1, At, B1); PG8_BAR;
            PG8_LDB(B0, 1, 0); PG8_SCHED; PG8_LDA(At, 1, 0); PG8_STAGE(PG8_SA(0, 1), a2 + hstep, voffA);
            PG8_WAIT_L(8); PG8_BAR; PG8_WAIT_L(0); PG8_MMA(0, 0, At, B0); PG8_BAR; PG8_SCHED;
            PG8_LDB(B1, 1, 1); PG8_STAGE(PG8_SB(1, 0), b3, voffB);
            PG8_BAR; PG8_WAIT_L(0); PG8_MMA(0, 1, At, B1); PG8_BAR;
            PG8_LDA(At, 1, 1); PG8_STAGE(PG8_SA(1, 0), a3, voffA);
            PG8_BAR; PG8_WAIT_L(0); PG8_MMA(1, 0, At, B0); PG8_BAR; PG8_SCHED;
            PG8_STAGE(PG8_SB(1, 1), b3 + hstep, voffB);
            PG8_WAIT_V(6); PG8_BAR; PG8_MMA(1, 1, At, B1); PG8_BAR;
            }
        }
        if constexpr (ALIGN_EPI) { if (wr == 0) PG8_BAR; }
        if constexpr (!Epi::AFTER_DRAIN) { E(acc, cur, wr, wc, fr, fq); S.done(cur); }
        if (!has_next) break;
#pragma unroll
        for (int a = 0; a < 2; ++a)
#pragma unroll
            for (int b = 0; b < 2; ++b)
#pragma unroll
                for (int m = 0; m < 4; ++m)
#pragma unroll
                    for (int n = 0; n < 2; ++n) acc[a][b][m][n] = (f32x4){0.f, 0.f, 0.f, 0.f};
        cur = nxt; cA = nA; cB = nB; ++ui;
        if constexpr (ALIGN_EPI) { if (wr == 1) PG8_BAR; }
    }
    PG8_WAIT_V(0);
    if constexpr (!ALIGN_EPI) { if (wr == 0) PG8_BAR; }
    PG8_BAR;
    if constexpr (Epi::AFTER_DRAIN) { E.fused(acc, cur, wr, wc, fr, fq, lds, wid, lane); S.done(cur); }
#undef PG8_SA
#undef PG8_SB
#undef PG8_STAGE
#undef PG8_LDA
#undef PG8_LDB
#undef PG8_MMA
#undef PG8_WAIT_V
#undef PG8_WAIT_L
#undef PG8_BAR
#undef PG8_SCHED
}
}


#define LAS __attribute__((address_space(3)))
using pg8::bf16_t; using pg8::bf16x8; using pg8::f32x4;
typedef unsigned u32x2 __attribute__((ext_vector_type(2)));
typedef unsigned u32x4 __attribute__((ext_vector_type(4)));

constexpr int TP = 16384, TS = 256, TT = TP + TS;
constexpr int NSLOT = 1056;
constexpr size_t MiB = 1u << 20;
constexpr size_t W_LAYER = 24 * MiB, W_IN = 0, W_OUT = 6 * MiB, W_UP = 8 * MiB, W_DOWN = 16 * MiB;
constexpr size_t WS_ACT = 48 * MiB;
constexpr size_t WS_A = WS_ACT + (size_t)TT * 1024 * 2;
constexpr size_t WS_UC = WS_A + (size_t)TT * 3072 * 2;
constexpr size_t SLOT16 = (size_t)NSLOT * 8192 * 2;
constexpr size_t WS_WC = WS_UC + SLOT16;
constexpr size_t WS_B = WS_WC + SLOT16;
constexpr size_t WS_QG = WS_B, WS_KGT = WS_QG + SLOT16, WS_ATT = WS_KGT + SLOT16;
constexpr size_t WS_MOD = WS_ATT + (size_t)NSLOT * 4096 * 2;
constexpr size_t WS_BG = WS_MOD + 2 * 16 * 6144 * 4;
constexpr size_t WS_GL = WS_BG + (size_t)TT * 8 * 4;
constexpr size_t WS_BAR = (WS_GL + NSLOT * 4 + 511) / 256 * 256;
constexpr size_t WS_END = WS_BAR + 3456 * 4 + 256;
static_assert(WS_A + (size_t)TT * 4096 * 2 <= WS_B, "hidden overlay");
static_assert(WS_B + (size_t)TT * 1024 * 2 <= WS_ATT, "hbuf overlay");
static_assert(WS_END <= 256 * MiB, "ws");
constexpr size_t O_YS = (size_t)TP * 1024, O_PCONV = O_YS + (size_t)TS * 1024, O_PDELTA = O_PCONV + 2 * 8 * 3 * 1536,
                 O_SCONV = O_PDELTA + 2 * 8 * 4 * 128 * 128, O_SDELTA = O_SCONV + 2 * 8 * 3 * 1536, O_SGUV = O_SDELTA + 2 * 8 * 4 * 128 * 128,
                 O_END = O_SGUV + 2 * 8 * 32 * 512;
constexpr int LDS_BYTES = 156 * 1024;

struct Params { const float* in[22]; float* out; unsigned char* ws; int ph_lo, ph_hi; };

typedef __bf16 hwbf2 __attribute__((ext_vector_type(2)));
typedef float f32x2_t __attribute__((ext_vector_type(2)));
__device__ __forceinline__ unsigned pk2(float lo, float hi) { const f32x2_t v = {lo, hi}; return __builtin_bit_cast(unsigned, __builtin_convertvector(v, hwbf2)); }
__device__ __forceinline__ unsigned short f2bf(float f) { return (unsigned short)(pk2(f, 0.f) & 0xffffu); }
__device__ __forceinline__ float bf2f(unsigned short b) { return __uint_as_float(((unsigned)b) << 16); }
__device__ __forceinline__ float bflo(unsigned w) { return __uint_as_float(w << 16); }
__device__ __forceinline__ float bfhi(unsigned w) { return __uint_as_float(w & 0xffff0000u); }
__device__ __forceinline__ float wave_sum(float v) {
#pragma unroll
    for (int o = 32; o >= 1; o >>= 1) v += __shfl_xor(v, o);
    return v; }
__device__ __forceinline__ float silu_f(float x) { return x * __builtin_amdgcn_rcpf(1.f + __expf(-x)); }
__device__ __forceinline__ float sigmoid_f(float x) { return __builtin_amdgcn_rcpf(1.f + __expf(-x)); }
__device__ __forceinline__ float gelu_tanh(float x) { return x * __builtin_amdgcn_rcpf(1.f + __expf(-1.5957691216f * (x + 0.044715f * x * x * x))); }
__device__ __forceinline__ int row_tb(int r) { return r < TP ? (r >> 11) : 8 + ((r - TP) >> 5); }
__device__ __forceinline__ bf16x8 mk8(unsigned a, unsigned b, unsigned c, unsigned d) { u32x4 v = {a, b, c, d}; return __builtin_bit_cast(bf16x8, v); }
__device__ __forceinline__ int tid_l() { int t = threadIdx.x; asm volatile("" : "+v"(t)); return t; }
__device__ __forceinline__ int bid_l() { int t = blockIdx.x; asm volatile("" : "+s"(t)); return t; }
__device__ __forceinline__ bf16_t* xb_ptr(const Params& P) { return (bf16_t*)((unsigned char*)P.out + (size_t)TT * 2048); }
__device__ __forceinline__ f32x4 bf4(u32x2 t) { return (f32x4){bflo(t.x), bfhi(t.x), bflo(t.y), bfhi(t.y)}; }
#define MFMA16(a, b, c) __builtin_amdgcn_mfma_f32_16x16x32_bf16((a), (b), (c), 0, 0, 0)

struct EpiP {
    static constexpr bool PERM = true, AFTER_DRAIN = false;
    bf16_t* O;
    __device__ __forceinline__ void operator()(const f32x4 (&acc)[2][2][4][2], const pg8::Unit& u, int wr, int wc, int fr, int fq) const {
        const int row0 = u.pm * 256 + wr * 64 + fr, col0 = u.pn * 256 + wc * 32 + 8 * fq; const bool act = u.pn < 4, zact = u.pn >= 10;
#pragma unroll
        for (int ai = 0; ai < 2; ++ai)
#pragma unroll
            for (int m = 0; m < 4; ++m) { bf16_t* rowp = O + (size_t)(row0 + ai * 128 + m * 16) * 3072 + col0;
#pragma unroll
                for (int bj = 0; bj < 2; ++bj) { f32x4 v0 = acc[ai][bj][m][0], v1 = acc[ai][bj][m][1];
                    if (act) {
#pragma unroll
                        for (int j = 0; j < 4; ++j) { v0[j] = gelu_tanh(v0[j]); v1[j] = gelu_tanh(v1[j]); } }
                    if (zact) {
#pragma unroll
                        for (int j = 0; j < 4; ++j) { v0[j] = silu_f(v0[j]); v1[j] = silu_f(v1[j]); } }
                    u32x4 w; w.x = pg8::cvt_pk_bf16(v0[0], v0[1]); w.y = pg8::cvt_pk_bf16(v0[2], v0[3]); w.z = pg8::cvt_pk_bf16(v1[0], v1[1]); w.w = pg8::cvt_pk_bf16(v1[2], v1[3]);
                    *(u32x4*)(rowp + bj * 128) = w; } }
    }
    __device__ __forceinline__ void row8(int r, int c, const float (&v)[8]) const {
        float t[8];
#pragma unroll
        for (int j = 0; j < 8; ++j) t[j] = c < 1024 ? gelu_tanh(v[j]) : (c >= 2560 ? silu_f(v[j]) : v[j]);
        u32x4 w; w.x = pk2(t[0], t[1]); w.y = pk2(t[2], t[3]); w.z = pk2(t[4], t[5]); w.w = pk2(t[6], t[7]);
        *(u32x4*)(O + (size_t)r * 3072 + c) = w; }
};
struct EpiH {
    static constexpr bool PERM = true, AFTER_DRAIN = false;
    bf16_t* O;
    __device__ __forceinline__ void operator()(const f32x4 (&acc)[2][2][4][2], const pg8::Unit& u, int wr, int wc, int fr, int fq) const {
        const int row0 = u.pm * 256 + wr * 64 + fr, col0 = u.pn * 256 + wc * 32 + 8 * fq;
#pragma unroll
        for (int ai = 0; ai < 2; ++ai)
#pragma unroll
            for (int m = 0; m < 4; ++m) { bf16_t* rowp = O + (size_t)(row0 + ai * 128 + m * 16) * 4096 + col0;
#pragma unroll
                for (int bj = 0; bj < 2; ++bj) { f32x4 v0 = acc[ai][bj][m][0], v1 = acc[ai][bj][m][1];
#pragma unroll
                    for (int j = 0; j < 4; ++j) { const float a = fmaxf(v0[j], 0.f), b = fmaxf(v1[j], 0.f); v0[j] = a * a; v1[j] = b * b; }
                    u32x4 w; w.x = pg8::cvt_pk_bf16(v0[0], v0[1]); w.y = pg8::cvt_pk_bf16(v0[2], v0[3]); w.z = pg8::cvt_pk_bf16(v1[0], v1[1]); w.w = pg8::cvt_pk_bf16(v1[2], v1[3]);
                    *(u32x4*)(rowp + bj * 128) = w; } }
    }
    __device__ __forceinline__ void row8(int r, int c, const float (&v)[8]) const {
        float t[8];
#pragma unroll
        for (int j = 0; j < 8; ++j) { const float a = fmaxf(v[j], 0.f); t[j] = a * a; }
        u32x4 w; w.x = pk2(t[0], t[1]); w.y = pk2(t[2], t[3]); w.z = pk2(t[4], t[5]); w.w = pk2(t[6], t[7]);
        *(u32x4*)(O + (size_t)r * 4096 + c) = w; }
};
struct EpiRes {
    static constexpr bool PERM = true, AFTER_DRAIN = false;
    const float* base_p; const float* base_s; bf16_t* xb; const float* gate; int basef32;
    __device__ __forceinline__ void operator()(const f32x4 (&acc)[2][2][4][2], const pg8::Unit& u, int wr, int wc, int fr, int fq) const {
        const int row0 = u.pm * 256 + wr * 64 + fr, col0 = u.pn * 256 + wc * 32 + 8 * fq;
#pragma unroll
        for (int ai = 0; ai < 2; ++ai)
#pragma unroll
            for (int m = 0; m < 4; ++m) { const int r = row0 + ai * 128 + m * 16; const float* gp = gate + row_tb(r) * 6144; bf16_t* xr = xb + (size_t)r * 1024;
#pragma unroll
                for (int bj = 0; bj < 2; ++bj) { const int c = col0 + bj * 128; const f32x4 g0 = *(const f32x4*)(gp + c), g1 = *(const f32x4*)(gp + c + 4); f32x4 b0, b1;
                    if (basef32) { const float* bp = (r < TP) ? base_p + (size_t)r * 1024 : base_s + (size_t)(r - TP) * 1024; b0 = *(const f32x4*)(bp + c); b1 = *(const f32x4*)(bp + c + 4); }
                    else { const u32x4 raw = *(const u32x4*)(xr + c); b0 = bf4((u32x2){raw.x, raw.y}); b1 = bf4((u32x2){raw.z, raw.w}); }
                    const f32x4 x0 = b0 + g0 * acc[ai][bj][m][0], x1 = b1 + g1 * acc[ai][bj][m][1];
                    *(u32x4*)(xr + c) = (u32x4){pk2(x0[0], x0[1]), pk2(x0[2], x0[3]), pk2(x1[0], x1[1]), pk2(x1[2], x1[3])}; } }
    }
    __device__ __forceinline__ void row8(int r, int c, const float (&v)[8]) const {
        const float* gp = gate + row_tb(r) * 6144 + c; bf16_t* xr = xb + (size_t)r * 1024 + c;
        const f32x4 g0 = *(const f32x4*)gp, g1 = *(const f32x4*)(gp + 4); f32x4 b0, b1;
        if (basef32) { const float* bp = base_s + (size_t)(r - TP) * 1024 + c; b0 = *(const f32x4*)bp; b1 = *(const f32x4*)(bp + 4); }
        else { const u32x4 raw = *(const u32x4*)xr; b0 = bf4((u32x2){raw.x, raw.y}); b1 = bf4((u32x2){raw.z, raw.w}); }
        const f32x4 x0 = b0 + g0 * (f32x4){v[0], v[1], v[2], v[3]}, x1 = b1 + g1 * (f32x4){v[4], v[5], v[6], v[7]};
        *(u32x4*)xr = (u32x4){pk2(x0[0], x0[1]), pk2(x0[2], x0[3]), pk2(x1[0], x1[1]), pk2(x1[2], x1[3])}; }
};
template <bool ALIGN, class Epi> __device__ __forceinline__ void run_gemm(LAS unsigned char* lds, const bf16_t* A, const bf16_t* Bt, int N, int K, const Epi& E) {
    pg8::Gemm g; g.A = A; g.Bt = Bt; g.M = TP; g.N = N; g.K = K;
    pg8::StaticOrder S; S.init(TP, N, (int)gridDim.x, bid_l());
    pg8::gemm_phase<Epi, pg8::StaticOrder, ALIGN, true>(lds, g, S, E);
}
template <int TM, int TN, int UNR, class Epi> __device__ __forceinline__ void small_gemm(LAS unsigned char* lds, const bf16_t* A, const bf16_t* Bt, int N, int K, const Epi& E) {
    constexpr int MT = TM / 16, NT = TN / 16;
    const int tid = tid_l(), lane = tid & 63, wave = tid >> 6, x = lane & 15, kq = lane >> 4;
    const int ntn = N / TN, ntiles = (TS / TM) * ntn, kw = K / 8;
    LAS float* red = (LAS float*)lds;
    for (int t = bid_l(); t < ntiles; t += gridDim.x) {
        const int tm = t / ntn, tn = t - tm * ntn;
        const bf16_t* ap = A + (size_t)(TP + tm * TM + x) * K + wave * kw + kq * 8;
        const bf16_t* bp = Bt + (size_t)(tn * TN + x) * K + wave * kw + kq * 8;
        f32x4 acc[NT][MT];
#pragma unroll
        for (int nt = 0; nt < NT; ++nt)
#pragma unroll
            for (int mt = 0; mt < MT; ++mt) acc[nt][mt] = (f32x4){0.f, 0.f, 0.f, 0.f};
        for (int ks0 = 0; ks0 < kw / 32; ks0 += UNR) {
            bf16x8 af[UNR][MT], bfr[UNR][NT];
#pragma unroll
            for (int j = 0; j < UNR; ++j) {
#pragma unroll
                for (int mt = 0; mt < MT; ++mt) af[j][mt] = *(const bf16x8*)(ap + (size_t)mt * 16 * K + (ks0 + j) * 32);
#pragma unroll
                for (int nt = 0; nt < NT; ++nt) bfr[j][nt] = *(const bf16x8*)(bp + (size_t)nt * 16 * K + (ks0 + j) * 32); }
            __builtin_amdgcn_sched_barrier(0);
#pragma unroll
            for (int j = 0; j < UNR; ++j)
#pragma unroll
                for (int nt = 0; nt < NT; ++nt)
#pragma unroll
                    for (int mt = 0; mt < MT; ++mt) acc[nt][mt] = MFMA16(bfr[j][nt], af[j][mt], acc[nt][mt]);
            __builtin_amdgcn_sched_barrier(0);
        }
#pragma unroll
        for (int nt = 0; nt < NT; ++nt)
#pragma unroll
            for (int mt = 0; mt < MT; ++mt) *(LAS f32x4*)(red + wave * TM * TN + (16 * mt + x) * TN + 16 * nt + kq * 4) = acc[nt][mt];
        __syncthreads();
        if (tid < TM * TN / 8) { const int r = tid / (TN / 8), c8 = (tid % (TN / 8)) * 8; float v[8];
#pragma unroll
            for (int j = 0; j < 8; ++j) v[j] = 0.f;
#pragma unroll
            for (int w = 0; w < 8; ++w) { const f32x4 a = *(const LAS f32x4*)(red + w * TM * TN + r * TN + c8), c = *(const LAS f32x4*)(red + w * TM * TN + r * TN + c8 + 4);
                v[0] += a[0]; v[1] += a[1]; v[2] += a[2]; v[3] += a[3]; v[4] += c[0]; v[5] += c[1]; v[6] += c[2]; v[7] += c[3]; }
            E.row8(TP + tm * TM + r, tn * TN + c8, v); }
        __syncthreads();
    }
}

__device__ __forceinline__ void transpose_tile4(const float* W, int ldw, bf16_t* Bt, int ldb, int k0, int n0, LAS float* tile  ) {
    const int tid = tid_l(), ty = tid >> 6, tx = tid & 63;
    f32x4 v[8];
#pragma unroll
    for (int i = 0; i < 8; ++i) v[i] = *(const f32x4*)(W + (size_t)(k0 + ty + 8 * i) * ldw + n0 + tx * 4);
#pragma unroll
    for (int i = 0; i < 8; ++i) { const int k = ty + 8 * i; tile[k * 261 + tx * 4 + 0] = v[i][0]; tile[k * 261 + tx * 4 + 1] = v[i][1]; tile[k * 261 + tx * 4 + 2] = v[i][2]; tile[k * 261 + tx * 4 + 3] = v[i][3]; }
    __syncthreads();
#pragma unroll
    for (int i = 0; i < 4; ++i) { const int n = (tid >> 3) + 64 * i, kq = tid & 7; u32x4 w;
        w.x = pk2(tile[(kq * 8 + 0) * 261 + n], tile[(kq * 8 + 1) * 261 + n]); w.y = pk2(tile[(kq * 8 + 2) * 261 + n], tile[(kq * 8 + 3) * 261 + n]);
        w.z = pk2(tile[(kq * 8 + 4) * 261 + n], tile[(kq * 8 + 5) * 261 + n]); w.w = pk2(tile[(kq * 8 + 6) * 261 + n], tile[(kq * 8 + 7) * 261 + n]);
        *(u32x4*)(Bt + (size_t)(n0 + n) * ldb + k0 + kq * 8) = w; }
    __syncthreads();
}
__device__ __forceinline__ void phase0(const Params& P, LAS unsigned char* lds) {
    const int tid = tid_l(), lane = tid & 63, wave = tid >> 6, G = gridDim.x, bid = bid_l();
    float* mod = (float*)(P.ws + WS_MOD);
    if (bid < 192) {
        LAS float* cs = (LAS float*)lds;
        LAS float* red = (LAS float*)(lds + 65536);
        for (int i = tid; i < 16384; i += 512) { const int tb = i >> 10, k = i & 1023; const float c = tb < 8 ? P.in[2][tb * 1024 + k] : P.in[3][(tb - 8) * 1024 + k]; cs[k * 16 + tb] = silu_f(c); }
        __syncthreads();
        for (int item = bid; item < 192; item += G) {
            const int l = item / 96, cgp = item % 96, j = cgp * 64 + lane;
            const float* wp = P.in[6] + ((size_t)l * 1024 + wave * 128) * 6144 + j;
            float acc[16];
#pragma unroll
            for (int t = 0; t < 16; ++t) acc[t] = 0.f;
#pragma unroll 16
            for (int kk = 0; kk < 128; ++kk) { const float wv = wp[(size_t)kk * 6144]; const LAS f32x4* c4 = (const LAS f32x4*)(cs + (wave * 128 + kk) * 16);
#pragma unroll
                for (int q = 0; q < 4; ++q) { const f32x4 cv = c4[q]; acc[4 * q + 0] += cv[0] * wv; acc[4 * q + 1] += cv[1] * wv; acc[4 * q + 2] += cv[2] * wv; acc[4 * q + 3] += cv[3] * wv; } }
#pragma unroll
            for (int t = 0; t < 16; ++t) red[(wave * 16 + t) * 64 + lane] = acc[t];
            __syncthreads();
            for (int o = tid; o < 1024; o += 512) { const int tb = o >> 6, ln = o & 63; float s = P.in[7][l * 6144 + cgp * 64 + ln];
#pragma unroll
                for (int w = 0; w < 8; ++w) s += red[(w * 16 + tb) * 64 + ln];
                mod[(size_t)(l * 16 + tb) * 6144 + cgp * 64 + ln] = s; }
            __syncthreads();
        }
    }
    __syncthreads();
    LAS float* tile = (LAS float*)lds;
    for (int it = bid; it < 1536; it += G) {
        const int l = it / 768; int r = it % 768; const float* W; int ldw, K, kt, nt; bf16_t* Bt;
        if (r < 192) { W = P.in[10] + (size_t)l * 1024 * 3080; ldw = 3080; K = 1024; Bt = (bf16_t*)(P.ws + l * W_LAYER + W_IN); kt = r / 12; nt = r % 12; }
        else if (r < 256) { r -= 192; W = P.in[18] + (size_t)l * 1024 * 1024; ldw = 1024; K = 1024; Bt = (bf16_t*)(P.ws + l * W_LAYER + W_OUT); kt = r / 4; nt = r % 4; }
        else if (r < 512) { r -= 256; W = P.in[19] + (size_t)l * 1024 * 4096; ldw = 4096; K = 1024; Bt = (bf16_t*)(P.ws + l * W_LAYER + W_UP); kt = r / 16; nt = r % 16; }
        else { r -= 512; W = P.in[20] + (size_t)l * 4096 * 1024; ldw = 1024; K = 4096; Bt = (bf16_t*)(P.ws + l * W_LAYER + W_DOWN); kt = r / 4; nt = r % 4; }
        transpose_tile4(W, ldw, Bt, K, kt * 64, nt * 256, tile);
    }
}

template <bool MIX> __device__ __forceinline__ void phase_h(const Params& P, int l, LAS unsigned char* lds) {
    const int tid = tid_l(), lane = tid & 63, wave = tid >> 6;
    const float* gamma = (MIX ? P.in[8] : P.in[9]) + l * 1024;
    const float* mod = (const float*)(P.ws + WS_MOD) + (size_t)l * 16 * 6144;
    const int shoff = MIX ? 0 : 3072, scoff = MIX ? 1024 : 4096;
    bf16_t* hbuf = (bf16_t*)(P.ws + WS_B);
    float* bg = (float*)(P.ws + WS_BG);
    const float* wab = P.in[10] + (size_t)l * 1024 * 3080 + 3072;
    LAS float* wT = (LAS float*)lds;
    if (MIX) {
#pragma unroll
        for (int i = 0; i < 2; ++i) { const int j = tid + 512 * i; const f32x4 w0 = *(const f32x4*)(wab + (size_t)j * 3080), w1 = *(const f32x4*)(wab + (size_t)j * 3080 + 4);
            wT[j] = w0[0]; wT[1024 + j] = w0[1]; wT[2048 + j] = w0[2]; wT[3072 + j] = w0[3]; wT[4096 + j] = w1[0]; wT[5120 + j] = w1[1]; wT[6144 + j] = w1[2]; wT[7168 + j] = w1[3]; }
        __syncthreads();
    }
    const int gw = bid_l() * 8 + wave;
    const bf16_t* xbp = xb_ptr(P);
#define LOADROW(dst, r_) do { if (MIX && l == 0) { const float* xr_ = (r_) < TP ? P.in[0] + (size_t)(r_) * 1024 : P.in[1] + (size_t)((r_) - TP) * 1024; \
            _Pragma("unroll") for (int i_ = 0; i_ < 4; ++i_) dst[i_] = *(const f32x4*)(xr_ + lane * 4 + 256 * i_); } \
        else { const bf16_t* xr_ = xbp + (size_t)(r_) * 1024; _Pragma("unroll") for (int i_ = 0; i_ < 4; ++i_) dst[i_] = bf4(*(const u32x2*)(xr_ + lane * 4 + 256 * i_)); } } while (0)
#define LOAD_MOD(tb_) do { const float* mp_ = mod + (tb_) * 6144; _Pragma("unroll") for (int i_ = 0; i_ < 4; ++i_) { const int j_ = lane * 4 + 256 * i_; \
        const f32x4 g4_ = *(const f32x4*)(gamma + j_), sc4_ = *(const f32x4*)(mp_ + scoff + j_); csv[i_] = g4_ * (sc4_ + 1.f); shv[i_] = *(const f32x4*)(mp_ + shoff + j_); } } while (0)
    if (gw * 8 >= TP) return;
    f32x4 csv[4], shv[4], v[4];
    LOADROW(v, gw * 8);
    LOAD_MOD((gw * 8) >> 11);
    const int nrows = gw < TS ? 9 : 8;
    for (int it = 0; it < nrows; ++it) {
        const int r = it < 8 ? gw * 8 + it : TP + gw;
        f32x4 vnx[4];
        if (it + 1 < nrows) LOADROW(vnx, (it + 1 < 8 ? gw * 8 + it + 1 : TP + gw));
        if (it == 8) LOAD_MOD(8 + (gw >> 5));
        float ss = 0.f;
#pragma unroll
        for (int i = 0; i < 4; ++i) ss += v[i][0] * v[i][0] + v[i][1] * v[i][1] + v[i][2] * v[i][2] + v[i][3] * v[i][3];
        ss = wave_sum(ss);
        const float rstd = rsqrtf(ss * (1.f / 1024.f) + 1e-6f);
        float ab[8];
#pragma unroll
        for (int e = 0; e < 8; ++e) ab[e] = 0.f;
#pragma unroll
        for (int i = 0; i < 4; ++i) { const int j = lane * 4 + 256 * i;
            const f32x4 hv = v[i] * rstd * csv[i] + shv[i];
            u32x2 w; w.x = pk2(hv[0], hv[1]); w.y = pk2(hv[2], hv[3]);
            *(u32x2*)(hbuf + (size_t)r * 1024 + j) = w;
            if (MIX) {
#pragma unroll
                for (int c = 0; c < 8; ++c) { const f32x4 w4 = *(const LAS f32x4*)(wT + c * 1024 + j); ab[c] += hv[0] * w4[0] + hv[1] * w4[1] + hv[2] * w4[2] + hv[3] * w4[3]; }
                __builtin_amdgcn_sched_barrier(0); }
        }
        if (MIX) {
            const bool h1 = lane & 32, h2 = lane & 16, h3 = lane & 8;
            float k4[4], k2[2];
#pragma unroll
            for (int i = 0; i < 4; ++i) { const float send = h1 ? ab[i] : ab[4 + i]; k4[i] = (h1 ? ab[4 + i] : ab[i]) + __shfl_xor(send, 32); }
#pragma unroll
            for (int i = 0; i < 2; ++i) { const float send = h2 ? k4[i] : k4[2 + i]; k2[i] = (h2 ? k4[2 + i] : k4[i]) + __shfl_xor(send, 16); }
            float k1 = (h3 ? k2[1] : k2[0]) + __shfl_xor(h3 ? k2[0] : k2[1], 8);
            k1 += __shfl_xor(k1, 4); k1 += __shfl_xor(k1, 2); k1 += __shfl_xor(k1, 1);
            if ((lane & 7) == 0) { const int idx = lane >> 3, h = idx & 3;
                if (idx < 4) bg[(size_t)r * 8 + h] = sigmoid_f(k1);
                else { const float xx = k1 + P.in[15][l * 4 + h]; const float sp = xx > 20.f ? xx : log1pf(expf(xx)); bg[(size_t)r * 8 + 4 + h] = -expf(P.in[16][l * 4 + h]) * sp; } }
        }
#pragma unroll
        for (int i = 0; i < 4; ++i) v[i] = vnx[i];
    }
#undef LOADROW
#undef LOAD_MOD
}

template <int C> struct B1Raw { static constexpr int NCH = (C + 3) * 48, NB = (NCH + 511) / 512; };
template <int C> __device__ __forceinline__ void b1_issue(const Params& P, int l, int it, int tid, u32x4 (&rv)[B1Raw<C>::NB]) {
    const bool sample = it >= 1024; const int bh = sample ? it - 1024 : it >> 5, ci = sample ? 0 : it & 31, b = bh >> 2, h = bh & 3;
    const int row0 = sample ? TP + b * 32 : b * 2048 + ci * 64; const bool first = ci == 0;
    const bf16_t* p = (const bf16_t*)(P.ws + WS_A);
#pragma unroll
    for (int i = 0; i < B1Raw<C>::NB; ++i) { const int idx = tid + 512 * i; rv[i] = (u32x4){0u, 0u, 0u, 0u};
        if (idx < B1Raw<C>::NCH) { const int rr = idx / 48, cc = idx - rr * 48, tt = rr - 3, ch = (cc >> 4) * 512 + h * 128 + (cc & 15) * 8;
            if (tt >= 0 || !first) rv[i] = *(const u32x4*)(p + (size_t)(row0 + tt) * 3072 + 1024 + ch);
            else if (sample) { const float* sp = P.in[4] + ((size_t)(l * 8 + b) * 3 + rr) * 1536 + ch; const f32x4 a = *(const f32x4*)sp, c4 = *(const f32x4*)(sp + 4);
                rv[i] = (u32x4){pk2(a[0], a[1]), pk2(a[2], a[3]), pk2(c4[0], c4[1]), pk2(c4[2], c4[3])}; } } }
}
template <int C> __device__ __forceinline__ void b1_item(const Params& P, int l, int it, int nxt, u32x4 (&rv)[B1Raw<C>::NB], LAS unsigned char* lds) {
    constexpr int NT = C / 16;
    const int tid = tid_l(), lane = tid & 63, wave = tid >> 6;
    const bool sample = it >= 1024; const int slot = it, bh = sample ? it - 1024 : it >> 5, ci = sample ? 0 : it & 31, b = bh >> 2, h = bh & 3;
    const int row0 = sample ? TP + b * 32 : b * 2048 + ci * 64; const bool last = sample || ci == 31;
    LAS float* F0 = (LAS float*)lds;
    LAS float* F1 = (LAS float*)(lds + 33792);
    LAS float* F2 = (LAS float*)(lds + 67584);
    LAS bf16_t* QB = (LAS bf16_t*)(lds + 101376);
    LAS bf16_t* KB = (LAS bf16_t*)(lds + 118784);
    LAS bf16_t* KBB = (LAS bf16_t*)(lds + 136192);
    LAS float* rn = (LAS float*)(lds + 153600);
    LAS float* betas = rn + 128;
    LAS float* gcs = betas + 64;
    LAS float* egs = gcs + 64;
    LAS float* egls = egs + 64;
    const float* bg = (const float*)(P.ws + WS_BG);
    bf16_t* UC = (bf16_t*)(P.ws + WS_UC) + (size_t)slot * 8192; bf16_t* WC = (bf16_t*)(P.ws + WS_WC) + (size_t)slot * 8192;
    bf16_t* QG = (bf16_t*)(P.ws + WS_QG) + (size_t)slot * 8192; bf16_t* KGT = (bf16_t*)(P.ws + WS_KGT) + (size_t)slot * 8192;
    bf16_t* ATT = (bf16_t*)(P.ws + WS_ATT) + (size_t)slot * 4096;
    LAS bf16_t* RAW = QB;
#pragma unroll
    for (int i = 0; i < B1Raw<C>::NB; ++i) { const int idx = tid + 512 * i; if (idx < B1Raw<C>::NCH) *(LAS u32x4*)(RAW + idx * 8) = rv[i]; }
    __syncthreads();
    if (nxt >= 0) b1_issue<C>(P, l, nxt, tid, rv);
    if (tid < 384) {
        const int c = tid, which = c >> 7, d = c & 127, ch = which * 512 + h * 128 + d;
        const float* cw = P.in[14] + (size_t)l * 4 * 1536 + ch;
        const float w0 = cw[0], w1 = cw[1536], w2 = cw[3072], w3 = cw[4608];
        LAS float* F = which == 0 ? F0 : (which == 1 ? F1 : F2);
        float x0 = bf2f(RAW[c]), x1 = bf2f(RAW[384 + c]), x2 = bf2f(RAW[768 + c]);
#pragma unroll 8
        for (int t = 0; t < C; ++t) { const float x3 = bf2f(RAW[(t + 3) * 384 + c]); F[t * 132 + d] = silu_f(w0 * x0 + w1 * x1 + w2 * x2 + w3 * x3); x0 = x1; x1 = x2; x2 = x3; }
        if (last) { float* oc = P.out + (sample ? O_SCONV : O_PCONV) + (size_t)(l * 8 + b) * 3 * 1536;
            oc[ch] = x0; oc[1536 + ch] = x1; oc[3072 + ch] = x2; }
    } else if (wave == 6) {
        float gv = lane < C ? bg[(size_t)(row0 + lane) * 8 + 4 + h] : 0.f;
#pragma unroll
        for (int dd = 1; dd < 64; dd <<= 1) { const float n = __shfl_up(gv, dd); if (lane >= dd) gv += n; }
        const float gl_ = __shfl(gv, C - 1);
        if (lane < C) { gcs[lane] = gv; betas[lane] = bg[(size_t)(row0 + lane) * 8 + h]; egs[lane] = __expf(gv); egls[lane] = __expf(gl_ - gv); }
        if (lane == 0) ((float*)(P.ws + WS_GL))[slot] = __expf(gl_);
    }
    __syncthreads();
#pragma unroll
    for (int i = 0; i < (2 * C * 8) / 512; ++i) { const int idx = tid + 512 * i, ar = idx >> 3, part = idx & 7; const LAS float* src = (ar < C ? F0 + ar * 132 : F1 + (ar - C) * 132) + part * 16; float ss = 0.f;
#pragma unroll
        for (int j = 0; j < 4; ++j) { const f32x4 v = *(const LAS f32x4*)(src + 4 * j); ss += v[0] * v[0] + v[1] * v[1] + v[2] * v[2] + v[3] * v[3]; }
        ss += __shfl_xor(ss, 1); ss += __shfl_xor(ss, 2); ss += __shfl_xor(ss, 4);
        if (part == 0) rn[ar] = rsqrtf(ss + 1e-6f) * (ar < C ? 0.08838834764831845f : 1.f); }
    __syncthreads();
#pragma unroll
    for (int i = 0; i < (C * 32) / 512; ++i) { const int idx = tid + 512 * i, t = idx >> 5, d = (idx & 31) * 4;
        const f32x4 q4 = *(const LAS f32x4*)(F0 + t * 132 + d), k4 = *(const LAS f32x4*)(F1 + t * 132 + d), v4 = *(const LAS f32x4*)(F2 + t * 132 + d);
        const float rq = rn[t], rk = rn[C + t], bt = betas[t], eg = egs[t];
        const f32x4 qn = q4 * rq, kn = k4 * rk, kbt = kn * bt;
        *(LAS u32x2*)(QB + t * 136 + d) = (u32x2){pk2(qn[0], qn[1]), pk2(qn[2], qn[3])};
        *(LAS u32x2*)(KB + t * 136 + d) = (u32x2){pk2(kn[0], kn[1]), pk2(kn[2], kn[3])};
        *(LAS u32x2*)(KBB + t * 136 + d) = (u32x2){pk2(kbt[0], kbt[1]), pk2(kbt[2], kbt[3])};
        const f32x4 qe = qn * eg; *(u32x2*)(QG + t * 128 + d) = (u32x2){pk2(qe[0], qe[1]), pk2(qe[2], qe[3])};
        *(LAS f32x4*)(F0 + t * 132 + d) = kbt * eg; *(LAS f32x4*)(F2 + t * 132 + d) = v4 * bt; }
#pragma unroll
    for (int i = 0; i < (C * 16) / 512; ++i) { const int idx = tid + 512 * i, d = idx & 127, tg = idx >> 7; float kv[8];
#pragma unroll
        for (int j = 0; j < 8; ++j) { const int t = tg * 8 + j; kv[j] = F1[t * 132 + d] * rn[C + t] * egls[t]; }
        *(u32x4*)(KGT + d * 64 + tg * 8) = (u32x4){pk2(kv[0], kv[1]), pk2(kv[2], kv[3]), pk2(kv[4], kv[5]), pk2(kv[6], kv[7])}; }
    __syncthreads();
    LAS float* AdT = F1;
    LAS bf16_t* Abf = (LAS bf16_t*)(lds + 33792 + 4352);
    LAS float* UL = (LAS float*)(lds + 33792 + 13568);
    if (wave < 2 * NT) {
        const int prod = wave / NT, ti = wave % NT, m = lane & 15, kq = lane >> 4;
        const LAS bf16_t* Asrc = prod == 0 ? KBB : QB;
        for (int tj = 0; tj < NT; ++tj) {
            if (prod == 0 && tj > ti) break;
            f32x4 acc = {0.f, 0.f, 0.f, 0.f};
            if (tj <= ti) {
#pragma unroll
                for (int s = 0; s < 4; ++s) { const bf16x8 a = *(const LAS bf16x8*)(Asrc + (16 * ti + m) * 136 + 32 * s + kq * 8), bb = *(const LAS bf16x8*)(KB + (16 * tj + m) * 136 + 32 * s + kq * 8);
                    acc = MFMA16(a, bb, acc); }
            }
            const int j = 16 * tj + m; const float gj = gcs[j];
#pragma unroll
            for (int r = 0; r < 4; ++r) { const int i = 16 * ti + kq * 4 + r; const float dec = __expf(fminf(gcs[i] - gj, 0.f));
                if (prod == 0) { const float a = (i > j) ? acc[r] * dec : 0.f;
                    if (tj == ti) AdT[(ti * 16 + m) * 16 + kq * 4 + r] = a; else Abf[i * 72 + j] = f2bf(a); }
                else ATT[i * 64 + j] = f2bf((i >= j) ? acc[r] * dec : 0.f); }
        }
    }
    __syncthreads();
    {
        LAS bf16_t* XT = QB;
        const int c = tid & 255; const LAS float* rhs = (c < 128) ? (F2 + c) : (F0 + (c - 128));
        bf16_t* dst = ((c < 128) ? UC : WC) + (c & 127);
        int zoff; asm volatile("v_mov_b32 %0, 0" : "=v"(zoff));
        const LAS float* Az = AdT + zoff * 4;
        const int m = lane & 15, kq = lane >> 4;
#pragma unroll
        for (int bk = 0; bk < NT; ++bk) {
            if (bk > 0) {
#pragma unroll
                for (int cti = 0; cti < 2; ++cti) { const int ct = wave * 2 + cti; f32x4 acc = {0.f, 0.f, 0.f, 0.f};
#pragma unroll
                    for (int s = 0; s < (bk + 1) / 2; ++s) { const bool on = (32 * s + kq * 8) < 16 * bk;
                        u32x4 xa = *(const LAS u32x4*)(XT + (16 * ct + m) * 72 + 32 * s + kq * 8), ab = *(const LAS u32x4*)(Abf + (16 * bk + m) * 72 + 32 * s + kq * 8);
                        if (!on) { xa = (u32x4){0u, 0u, 0u, 0u}; ab = (u32x4){0u, 0u, 0u, 0u}; }
                        acc = MFMA16(__builtin_bit_cast(bf16x8, xa), __builtin_bit_cast(bf16x8, ab), acc); }
                    *(LAS f32x4*)(UL + m * 260 + 16 * ct + kq * 4) = acc; }
                __syncthreads();
            }
            if (tid < 256) {
                float x[16];
#pragma unroll
                for (int i = 0; i < 16; ++i) x[i] = rhs[(16 * bk + i) * 132] - (bk > 0 ? UL[i * 260 + c] : 0.f);
#pragma unroll
                for (int j = 0; j < 15; ++j)
#pragma unroll
                    for (int i = j + 1; i < 16; ++i) x[i] -= Az[(bk * 16 + j) * 16 + i] * x[j];
                const u32x4 w0 = {pk2(x[0], x[1]), pk2(x[2], x[3]), pk2(x[4], x[5]), pk2(x[6], x[7])}, w1 = {pk2(x[8], x[9]), pk2(x[10], x[11]), pk2(x[12], x[13]), pk2(x[14], x[15])};
                *(LAS u32x4*)(XT + c * 72 + 16 * bk) = w0; *(LAS u32x4*)(XT + c * 72 + 16 * bk + 8) = w1;
                if (c < 128) {
                    bf16_t* uf = UC + ((((c >> 4) * 4 + bk) * 64) + (c & 15)) * 4;
                    *(u32x2*)(uf) = (u32x2){w0[0], w0[1]}; *(u32x2*)(uf + 64) = (u32x2){w0[2], w0[3]}; *(u32x2*)(uf + 128) = (u32x2){w1[0], w1[1]}; *(u32x2*)(uf + 192) = (u32x2){w1[2], w1[3]};
                } else {
#pragma unroll
                    for (int i = 0; i < 4; ++i) { dst[(16 * bk + 2 * i) * 128] = (bf16_t)(w0[i] & 0xffffu); dst[(16 * bk + 2 * i + 1) * 128] = (bf16_t)(w0[i] >> 16);
                        dst[(16 * bk + 8 + 2 * i) * 128] = (bf16_t)(w1[i] & 0xffffu); dst[(16 * bk + 8 + 2 * i + 1) * 128] = (bf16_t)(w1[i] >> 16); } }
            }
            __syncthreads();
        }
    }
}
__device__ __forceinline__ void phase_b1(const Params& P, int l, LAS unsigned char* lds) {
    const int tid = tid_l(), G = gridDim.x; int it = bid_l();
    {
        u32x4 rv[B1Raw<64>::NB];
        if (it < 1024) b1_issue<64>(P, l, it, tid, rv);
        for (; it < 1024; it += G) { const int nx = it + G; b1_item<64>(P, l, it, nx < 1024 ? nx : -1, rv, lds); }
    }
    for (; it < NSLOT; it += G) { u32x4 rs[B1Raw<32>::NB]; b1_issue<32>(P, l, it, tid, rs); b1_item<32>(P, l, it, -1, rs, lds); }
}

__device__ __forceinline__ bf16x8 ldA(const LAS bf16_t* X, int ld, int row, int s, int kq) {
    const u32x2 lo = *(const LAS u32x2*)(X + row * ld + 32 * s + kq * 4), hi = *(const LAS u32x2*)(X + row * ld + 32 * s + 16 + kq * 4);
    return mk8(lo.x, lo.y, hi.x, hi.y); }
__device__ __forceinline__ bf16x8 packB(const f32x4& a, const f32x4& b) { return mk8(pk2(a[0], a[1]), pk2(a[2], a[3]), pk2(b[0], b[1]), pk2(b[2], b[3])); }
template <int C> __device__ __forceinline__ void scan_job(const Params& P, int l, int bh, int q, bool sample, LAS unsigned char* lds) {
    constexpr int MT = C / 16, KS = C / 32, NB3 = C / 32, BUF = 62464;
    const int tid = tid_l(), lane = tid & 63, wave = tid >> 6, m = lane & 15, kq = lane >> 4, b = bh >> 2, h = bh & 3;
    const bool active = wave < 2; const int ct = q * 2 + (wave & 1), vcol = ct * 16 + m;
    bf16_t* mixcat = (bf16_t*)(P.ws + WS_ACT);
    f32x4 S[8];
    if (sample && active) { const float* sd = P.in[5] + ((size_t)(l * 8 + b) * 4 + h) * 16384;
#pragma unroll
        for (int kt = 0; kt < 8; ++kt)
#pragma unroll
            for (int r = 0; r < 4; ++r) S[kt][r] = sd[(16 * kt + kq * 4 + r) * 128 + vcol];
    } else {
#pragma unroll
        for (int kt = 0; kt < 8; ++kt) S[kt] = (f32x4){0.f, 0.f, 0.f, 0.f};
    }
    const int nch = sample ? 1 : 32;
    u32x4 pfW[NB3], pfQ[NB3], pfA, pfK[2]; float glp;
#define SCAN_ISSUE(ci_) do { const int slot_ = sample ? 1024 + bh : bh * 32 + (ci_); \
        const bf16_t* gWC = (const bf16_t*)(P.ws + WS_WC) + (size_t)slot_ * 8192; const bf16_t* gQG = (const bf16_t*)(P.ws + WS_QG) + (size_t)slot_ * 8192; \
        const bf16_t* gKG = (const bf16_t*)(P.ws + WS_KGT) + (size_t)slot_ * 8192; \
        const bf16_t* gAT = (const bf16_t*)(P.ws + WS_ATT) + (size_t)slot_ * 4096; \
        _Pragma("unroll") for (int i_ = 0; i_ < NB3; ++i_) { const int idx_ = tid + 512 * i_, r_ = idx_ >> 4, c8_ = (idx_ & 15) * 8; \
            pfW[i_] = *(const u32x4*)(gWC + r_ * 128 + c8_); pfQ[i_] = *(const u32x4*)(gQG + r_ * 128 + c8_); } \
        if (tid < C * 8) pfA = *(const u32x4*)(gAT + (tid >> 3) * 64 + (tid & 7) * 8); \
        _Pragma("unroll") for (int i_ = 0; i_ < 2; ++i_) { const int idx_ = tid + 512 * i_; pfK[i_] = *(const u32x4*)(gKG + (idx_ >> 3) * 64 + (idx_ & 7) * 8); } \
        glp = ((const float*)(P.ws + WS_GL))[slot_]; } while (0)
#define U_ISSUE(ci_, dst_) do { if (active) { const bf16_t* gUC_ = (const bf16_t*)(P.ws + WS_UC) + (size_t)(sample ? 1024 + bh : bh * 32 + (ci_)) * 8192; \
        _Pragma("unroll") for (int mt_ = 0; mt_ < MT; ++mt_) dst_[mt_] = *(const u32x2*)(gUC_ + ((ct * 4 + mt_) * 64 + lane) * 4); } } while (0)
#define SCAN_STORE(par_) do { LAS bf16_t* W_ = (LAS bf16_t*)(lds + (par_) * BUF); LAS bf16_t* Q_ = (LAS bf16_t*)(lds + (par_) * BUF + 17408); \
        LAS bf16_t* A_ = (LAS bf16_t*)(lds + (par_) * BUF + 34816); LAS bf16_t* K_ = (LAS bf16_t*)(lds + (par_) * BUF + 44032); \
        _Pragma("unroll") for (int i_ = 0; i_ < NB3; ++i_) { const int idx_ = tid + 512 * i_, r_ = idx_ >> 4, c8_ = (idx_ & 15) * 8; \
            *(LAS u32x4*)(W_ + r_ * 136 + c8_) = pfW[i_]; *(LAS u32x4*)(Q_ + r_ * 136 + c8_) = pfQ[i_]; } \
        if (tid < C * 8) *(LAS u32x4*)(A_ + (tid >> 3) * 72 + (tid & 7) * 8) = pfA; \
        _Pragma("unroll") for (int i_ = 0; i_ < 2; ++i_) { const int idx_ = tid + 512 * i_; *(LAS u32x4*)(K_ + (idx_ >> 3) * 72 + (idx_ & 7) * 8) = pfK[i_]; } } while (0)
    u32x2 uc[MT], un[MT]; float gl, gln = 0.f;
#pragma unroll
    for (int mt = 0; mt < MT; ++mt) { uc[mt] = (u32x2){0u, 0u}; un[mt] = (u32x2){0u, 0u}; }
    SCAN_ISSUE(0);
    U_ISSUE(0, uc);
    SCAN_STORE(0);
    gl = glp;
    if (nch > 1) SCAN_ISSUE(1);
    __syncthreads();
    for (int ci = 0; ci < nch; ++ci) {
        const int par = ci & 1, row0 = sample ? TP + b * 32 : b * 2048 + ci * 64;
        if (ci + 1 < nch) {
            U_ISSUE(ci + 1, un);
            SCAN_STORE(par ^ 1);
            gln = glp;
            if (ci + 2 < nch) SCAN_ISSUE(ci + 2);
        }
        if (active) {
            const LAS bf16_t* WCs = (const LAS bf16_t*)(lds + par * BUF); const LAS bf16_t* QGs = (const LAS bf16_t*)(lds + par * BUF + 17408);
            const LAS bf16_t* ATs = (const LAS bf16_t*)(lds + par * BUF + 34816); const LAS bf16_t* KGs = (const LAS bf16_t*)(lds + par * BUF + 44032);
            bf16x8 Sb[4];
#pragma unroll
            for (int s = 0; s < 4; ++s) Sb[s] = packB(S[2 * s], S[2 * s + 1]);
            f32x4 vn[MT], oa[MT];
#pragma unroll
            for (int mt = 0; mt < MT; ++mt) { oa[mt] = (f32x4){0.f, 0.f, 0.f, 0.f};
                vn[mt] = (f32x4){-bflo(uc[mt].x), -bfhi(uc[mt].x), -bflo(uc[mt].y), -bfhi(uc[mt].y)}; }
            bf16x8 f0[4], f1[4];
#define SCAN_SB() __builtin_amdgcn_sched_barrier(0)
#define LD_ROWS(dst, X, ld, s_) _Pragma("unroll") for (int mt = 0; mt < MT; ++mt) dst[mt] = ldA(X, ld, 16 * mt + m, (s_), kq);
#define LD_KT(dst, s_, k0_) _Pragma("unroll") for (int kt = 0; kt < 4; ++kt) dst[kt] = ldA(KGs, 72, 16 * ((k0_) + kt) + m, (s_), kq);
#define MM_ROWS(acc, src, bop) _Pragma("unroll") for (int mt = 0; mt < MT; ++mt) acc[mt] = MFMA16(src[mt], (bop), acc[mt]);
#define MM_KT(src, bop, k0_) _Pragma("unroll") for (int kt = 0; kt < 4; ++kt) S[(k0_) + kt] = MFMA16(src[kt], (bop), S[(k0_) + kt]);
            LD_ROWS(f0, WCs, 136, 0); LD_ROWS(f1, WCs, 136, 1); SCAN_SB();
            MM_ROWS(vn, f0, Sb[0]); LD_ROWS(f0, WCs, 136, 2); SCAN_SB();
            MM_ROWS(vn, f1, Sb[1]); LD_ROWS(f1, WCs, 136, 3); SCAN_SB();
            MM_ROWS(vn, f0, Sb[2]); LD_ROWS(f0, QGs, 136, 0); SCAN_SB();
            MM_ROWS(vn, f1, Sb[3]); LD_ROWS(f1, QGs, 136, 1); SCAN_SB();
            MM_ROWS(oa, f0, Sb[0]); LD_ROWS(f0, QGs, 136, 2); SCAN_SB();
            MM_ROWS(oa, f1, Sb[1]); LD_ROWS(f1, QGs, 136, 3); SCAN_SB();
            MM_ROWS(oa, f0, Sb[2]); LD_ROWS(f0, ATs, 72, 0); SCAN_SB();
            MM_ROWS(oa, f1, Sb[3]);
#pragma unroll
            for (int mt = 0; mt < MT; ++mt)
#pragma unroll
                for (int r = 0; r < 4; ++r) vn[mt][r] = -vn[mt][r];
            bf16x8 Vb[KS];
#pragma unroll
            for (int s = 0; s < KS; ++s) Vb[s] = packB(vn[2 * s], vn[2 * s + 1]);
#pragma unroll
            for (int kt = 0; kt < 8; ++kt) S[kt] = S[kt] * gl;
            if (KS == 2) {
                LD_ROWS(f1, ATs, 72, KS - 1); SCAN_SB();
                MM_ROWS(oa, f0, Vb[0]); LD_KT(f0, 0, 0); SCAN_SB();
                MM_ROWS(oa, f1, Vb[KS - 1]); LD_KT(f1, 0, 4); SCAN_SB();
                MM_KT(f0, Vb[0], 0); LD_KT(f0, KS - 1, 0); SCAN_SB();
                MM_KT(f1, Vb[0], 4); LD_KT(f1, KS - 1, 4); SCAN_SB();
                MM_KT(f0, Vb[KS - 1], 0); SCAN_SB();
                MM_KT(f1, Vb[KS - 1], 4);
            } else {
                LD_KT(f1, 0, 0); SCAN_SB();
                MM_ROWS(oa, f0, Vb[0]); LD_KT(f0, 0, 4); SCAN_SB();
                MM_KT(f1, Vb[0], 0); SCAN_SB();
                MM_KT(f0, Vb[0], 4);
            }
            { bf16_t* op = mixcat + (size_t)(row0 + kq * 4) * 1024 + 512 + h * 128 + vcol;
#pragma unroll
              for (int mt = 0; mt < MT; ++mt) {
#pragma unroll
                for (int r = 0; r < 4; ++r) { *op = f2bf(oa[mt][r]); op += 1024; asm volatile("" : "+v"(op)); }
                op += 12 * 1024; asm volatile("" : "+v"(op)); } }
#undef LD_ROWS
#undef LD_KT
#undef MM_KT
#undef MM_ROWS
#undef SCAN_SB
        }
        __syncthreads();
#pragma unroll
        for (int mt = 0; mt < MT; ++mt) uc[mt] = un[mt];
        gl = gln;
    }
#undef SCAN_ISSUE
#undef SCAN_STORE
#undef U_ISSUE
    if (active) { float* od = P.out + (sample ? O_SDELTA : O_PDELTA) + ((size_t)(l * 8 + b) * 4 + h) * 16384;
#pragma unroll
        for (int kt = 0; kt < 8; ++kt)
#pragma unroll
            for (int r = 0; r < 4; ++r) od[(16 * kt + kq * 4 + r) * 128 + vcol] = S[kt][r]; }
    __syncthreads();
}
__device__ __forceinline__ void phase_gnorm(const Params& P, int l) {
    const int tid = tid_l(), lane = tid & 63, wave = tid >> 6;
    bf16_t* mixcat = (bf16_t*)(P.ws + WS_ACT); const bf16_t* p = (const bf16_t*)(P.ws + WS_A);
    const float* gn = P.in[17] + l * 128 + (lane & 15) * 8;
    const f32x4 g0 = *(const f32x4*)gn, g1 = *(const f32x4*)(gn + 4);
    const int rstride = gridDim.x * 8; int r = bid_l() * 8 + wave;
    u32x4 ov, zv;
    if (r < TT) { ov = *(const u32x4*)(mixcat + (size_t)r * 1024 + 512 + lane * 8); zv = *(const u32x4*)(p + (size_t)r * 3072 + 2560 + lane * 8); }
    for (; r < TT; r += rstride) {
        u32x4 on, zn; const int rn_ = r + rstride;
        if (rn_ < TT) { on = *(const u32x4*)(mixcat + (size_t)rn_ * 1024 + 512 + lane * 8); zn = *(const u32x4*)(p + (size_t)rn_ * 3072 + 2560 + lane * 8); }
        float o[8], z[8]; float ss = 0.f;
#pragma unroll
        for (int e = 0; e < 4; ++e) { o[2 * e] = bflo(ov[e]); o[2 * e + 1] = bfhi(ov[e]); z[2 * e] = bflo(zv[e]); z[2 * e + 1] = bfhi(zv[e]); }
#pragma unroll
        for (int e = 0; e < 8; ++e) ss += o[e] * o[e];
        ss += __shfl_xor(ss, 1); ss += __shfl_xor(ss, 2); ss += __shfl_xor(ss, 4); ss += __shfl_xor(ss, 8);
        const float rstd = rsqrtf(ss * (1.f / 128.f) + 1e-6f);
        u32x4 w; w.x = pk2(o[0] * rstd * g0[0] * z[0], o[1] * rstd * g0[1] * z[1]); w.y = pk2(o[2] * rstd * g0[2] * z[2], o[3] * rstd * g0[3] * z[3]);
        w.z = pk2(o[4] * rstd * g1[0] * z[4], o[5] * rstd * g1[1] * z[5]); w.w = pk2(o[6] * rstd * g1[2] * z[6], o[7] * rstd * g1[3] * z[7]);
        *(u32x4*)(mixcat + (size_t)r * 1024 + 512 + lane * 8) = w;
        ov = on; zv = zn;
    }
}

template <int PC> __device__ __forceinline__ void sgu_item(const Params& P, int l, int b, int row0, bool sample, int g0, int g1, LAS unsigned char* lds) {
    constexpr int LDV = PC + 8, KS = PC / 32;
#define SGU_SWZ(c_) ((((c_) >> 3) & (PC / 8 - 1)) << 3)
    const int tid = tid_l(), lane = tid & 63, wave = tid >> 6, m = lane & 15, kq = lane >> 4;
    LAS bf16_t* vT = (LAS bf16_t*)lds;
    LAS float* rstd = (LAS float*)(lds + 128 * LDV * 2);
    const bf16_t* p = (const bf16_t*)(P.ws + WS_A); bf16_t* mixcat = (bf16_t*)(P.ws + WS_ACT);
    { u32x4 rw[PC / 8];
#pragma unroll
        for (int i = 0; i < PC / 8; ++i) rw[i] = *(const u32x4*)(p + (size_t)(row0 + wave + 8 * i) * 3072 + 512 + lane * 8);
#pragma unroll
        for (int i = 0; i < PC / 8; ++i) { float ss = 0.f;
#pragma unroll
            for (int e = 0; e < 4; ++e) { const float a = bflo(rw[i][e]), c = bfhi(rw[i][e]); ss += a * a + c * c; }
            ss = wave_sum(ss); if (lane == 0) rstd[wave + 8 * i] = rsqrtf(ss * (1.f / 512.f) + 1e-6f); } }
    __syncthreads();
    for (int g = g0; g < g1; ++g) {
        const float* gam = P.in[11] + l * 512 + g * 128;
        constexpr int NBV = PC / 32;
        u32x4 rv[NBV];
#pragma unroll
        for (int i = 0; i < NBV; ++i) { const int idx = tid + 512 * i, q = idx >> 4, c8 = (idx & 15) * 8; rv[i] = *(const u32x4*)(p + (size_t)(row0 + q) * 3072 + 512 + g * 128 + c8); }
#pragma unroll
        for (int i = 0; i < NBV; ++i) { const int idx = tid + 512 * i, q = idx >> 4, c8 = (idx & 15) * 8; const u32x4 raw = rv[i]; const float rs = rstd[q];
#pragma unroll
            for (int e = 0; e < 8; ++e) { const float x = (e & 1) ? bfhi(raw[e >> 1]) : bflo(raw[e >> 1]); const float vn = x * rs * gam[c8 + e];
                vT[(c8 + e) * LDV + (q ^ SGU_SWZ(c8))] = f2bf(vn);
                if (sample) P.out[O_SGUV + ((size_t)(l * 8 + b) * 32 + q) * 512 + g * 128 + c8 + e] = vn; } }
        __syncthreads();
        int pt, ct0, nks;
        if (PC == 128) { pt = wave; ct0 = 0; nks = (pt < 4) ? 2 : 4; } else { pt = wave & 1; ct0 = (wave >> 1) * 2; nks = 1; }
        const int prow = 16 * pt + m; const float* wrow = P.in[12] + ((size_t)(l * 4 + g) * 128 + prow) * 128;
        bf16x8 Wf[KS];
#pragma unroll
        for (int s = 0; s < KS; ++s) { if (s < nks) { const f32x4 a = *(const f32x4*)(wrow + 32 * s + kq * 8), c = *(const f32x4*)(wrow + 32 * s + kq * 8 + 4);
                Wf[s] = mk8(pk2(a[0], a[1]), pk2(a[2], a[3]), pk2(c[0], c[1]), pk2(c[2], c[3])); } else Wf[s] = mk8(0u, 0u, 0u, 0u); }
        const float bias = P.in[13][(l * 4 + g) * 128 + prow];
        const size_t row = (size_t)(row0 + prow);
        constexpr int NCT = PC == 128 ? 8 : 2;
        u32x2 urv[NCT];
#pragma unroll
        for (int i = 0; i < NCT; ++i) urv[i] = *(const u32x2*)(p + row * 3072 + g * 128 + 16 * (ct0 + i) + kq * 4);
#pragma unroll
        for (int i = 0; i < NCT; ++i) { const int ct = ct0 + i; f32x4 acc = {0.f, 0.f, 0.f, 0.f};
#pragma unroll
            for (int s = 0; s < KS; ++s) if (s < nks) acc = MFMA16(*(const LAS bf16x8*)(vT + (16 * ct + m) * LDV + ((32 * s + kq * 8) ^ SGU_SWZ(16 * ct + m))), Wf[s], acc);
            const int ch = g * 128 + 16 * ct + kq * 4;
            const u32x2 ur = urv[i];
            u32x2 w; w.x = pk2(bflo(ur.x) * (acc[0] + bias), bfhi(ur.x) * (acc[1] + bias)); w.y = pk2(bflo(ur.y) * (acc[2] + bias), bfhi(ur.y) * (acc[3] + bias));
            *(u32x2*)(mixcat + row * 1024 + ch) = w; }
        __syncthreads();
    }
}
__device__ __forceinline__ void phase_scan_sgu(const Params& P, int l, LAS unsigned char* lds) {
    const int bid = bid_l(); const bool isScan = bid < 128; const int j = bid - 128;
    if (isScan) scan_job<64>(P, l, (bid & 7) + 8 * (bid >> 5), (bid >> 3) & 3, false, lds);
    else scan_job<32>(P, l, (j & 7) + 8 * (j >> 5), (j >> 3) & 3, true, lds);
    const int nq = isScan ? 1 : 3;
    for (int k = 0; k < nq; ++k) { const int qi = isScan ? 384 + bid : j + 128 * k; const int it = qi >> 2, g = qi & 3, b = it >> 4, n = it & 15;
        sgu_item<128>(P, l, b, b * 2048 + n * 128, false, g, g + 1, lds); }
    if (!isScan && j < 8) sgu_item<32>(P, l, j, TP + j * 32, true, 0, 4, lds);
}

#define XB_TMO      128
#define XB_XCNT(j)  (256  + 64 * (j))
#define XB_XSUB(j)  (1280 + 64 * (j))
#define XB_XGEN(j)  (2304 + 64 * (j))
#define XB_TOP      3328
#define XB_TOPGEN   3392
#define XCD_BAR_WORDS 3456
#define XB_SPIN_CAP (1u << 18)

__device__ __forceinline__ unsigned xb_ld(unsigned* p)              { return __hip_atomic_load(p, __ATOMIC_RELAXED, __HIP_MEMORY_SCOPE_AGENT); }
__device__ __forceinline__ unsigned xb_add(unsigned* p, unsigned v) { return __hip_atomic_fetch_add(p, v, __ATOMIC_RELAXED, __HIP_MEMORY_SCOPE_AGENT); }
__device__ __forceinline__ unsigned xb_xcc_id() { return (unsigned)__builtin_amdgcn_s_getreg((3 << 11) | 20) & 0xFu; }
#define XB_SPIN(cond, bar) do { unsigned _sp = 0; while (cond) { __builtin_amdgcn_s_sleep(1); \
    if ((++_sp & 255u) == 0u) { if (xb_ld(&(bar)[XB_TMO])) break; if (_sp > XB_SPIN_CAP) { atomicAdd(&(bar)[XB_TMO], 1u); break; } } } } while (0)

struct XcdBarrier {
    unsigned* bar; unsigned x;
    volatile LAS unsigned* st;
};

__device__ __forceinline__ XcdBarrier xcd_barrier_post(unsigned* bar, volatile LAS unsigned* st) {
    XcdBarrier b; b.bar = bar; b.x = xb_xcc_id(); b.st = st;
    if (threadIdx.x == 0) (void)xb_add(&bar[XB_XCNT(b.x)], 1u);
    return b;
}
__device__ __forceinline__ void xcd_barrier_complete(unsigned* bar, unsigned x, unsigned& nloc, unsigned& nx) {
    const unsigned G = gridDim.x * gridDim.y * gridDim.z;
    unsigned sum, cnt, mine, sp = 0u;
    for (;;) {
        sum = 0u; cnt = 0u; mine = 0u;
#pragma unroll
        for (unsigned j = 0; j < 16; ++j) { const unsigned c = xb_ld(&bar[XB_XCNT(j)]); sum += c; cnt += (c > 0u) ? 1u : 0u; mine = (j == x) ? c : mine; }
        if (sum == G) break;
        __builtin_amdgcn_s_sleep(1);
        if ((++sp & 255u) == 0u) { if (xb_ld(&bar[XB_TMO])) break; if (sp > XB_SPIN_CAP) { atomicAdd(&bar[XB_TMO], 1u); break; } }
    }
    nloc = mine > 0u ? mine : 1u; nx = cnt > 0u ? cnt : 1u;
}

__device__ __forceinline__ void xcd_barrier(const XcdBarrier& b) {
    asm volatile("s_waitcnt vmcnt(0)" ::: "memory");
    __syncthreads();
    if (threadIdx.x == 0) {
        unsigned* bar = b.bar;
        __builtin_amdgcn_s_waitcnt(0);
        unsigned nloc = b.st[0], nx = b.st[1];
        if (nloc == 0u) { xcd_barrier_complete(bar, b.x, nloc, nx); b.st[0] = nloc; b.st[1] = nx; }
        const unsigned old = xb_add(&bar[XB_XSUB(b.x)], 1u);
        const unsigned gen = old / nloc;
        if (old + 1u == (gen + 1u) * nloc) {
            __builtin_amdgcn_fence(__ATOMIC_RELEASE, "agent");
            asm volatile("s_waitcnt vmcnt(0)" ::: "memory");
            const unsigned og = xb_add(&bar[XB_TOP], 1u);
            const unsigned tg = og / nx;
            if (og + 1u == (tg + 1u) * nx) xb_add(&bar[XB_TOPGEN], 1u);
            else XB_SPIN(xb_ld(&bar[XB_TOPGEN]) == tg, bar);
            __builtin_amdgcn_fence(__ATOMIC_ACQUIRE, "agent");
            xb_add(&bar[XB_XGEN(b.x)], 1u);
            asm volatile("s_waitcnt vmcnt(0)" ::: "memory");
        } else {
            XB_SPIN(xb_ld(&bar[XB_XGEN(b.x)]) == gen, bar);
            __builtin_amdgcn_fence(__ATOMIC_ACQUIRE, "agent");
            asm volatile("s_waitcnt vmcnt(0)" ::: "memory");
        }
    }
    __syncthreads();
}

__device__ __forceinline__ void phase_final(const Params& P, const XcdBarrier& bar) {
    const int tid = tid_l(), lane = tid & 63, wave = tid >> 6, gw = bid_l() * 8 + wave;
    const bf16_t* xb = xb_ptr(P);
    constexpr int HALF_ROWS = TT / 2;
    f32x4 g4[4];
#pragma unroll
    for (int i = 0; i < 4; ++i) g4[i] = *(const f32x4*)(P.in[21] + lane * 4 + 256 * i);
    u32x2 up[5][4];
#pragma unroll
    for (int k = 0; k < 5; ++k) { const int r = HALF_ROWS + gw + 2048 * k;
#pragma unroll
        for (int i = 0; i < 4; ++i) up[k][i] = r < TT ? *(const u32x2*)(xb + (size_t)r * 1024 + lane * 4 + 256 * i) : (u32x2){0u, 0u}; }
    for (int r = gw; r < HALF_ROWS; r += 2048) { f32x4 v[4]; float ss = 0.f;
#pragma unroll
        for (int i = 0; i < 4; ++i) { v[i] = bf4(*(const u32x2*)(xb + (size_t)r * 1024 + lane * 4 + 256 * i)); ss += v[i][0] * v[i][0] + v[i][1] * v[i][1] + v[i][2] * v[i][2] + v[i][3] * v[i][3]; }
        ss = wave_sum(ss); const float rstd = rsqrtf(ss * (1.f / 1024.f) + 1e-6f);
#pragma unroll
        for (int i = 0; i < 4; ++i) *(f32x4*)(P.out + (size_t)r * 1024 + lane * 4 + 256 * i) = v[i] * rstd * g4[i]; }
    xcd_barrier(bar);
#pragma unroll
    for (int k = 0; k < 5; ++k) { const int r = HALF_ROWS + gw + 2048 * k;
        if (r < TT) { f32x4 v[4]; float ss = 0.f;
#pragma unroll
            for (int i = 0; i < 4; ++i) { v[i] = bf4(up[k][i]); ss += v[i][0] * v[i][0] + v[i][1] * v[i][1] + v[i][2] * v[i][2] + v[i][3] * v[i][3]; }
            ss = wave_sum(ss); const float rstd = rsqrtf(ss * (1.f / 1024.f) + 1e-6f);
#pragma unroll
            for (int i = 0; i < 4; ++i) *(f32x4*)(P.out + (size_t)r * 1024 + lane * 4 + 256 * i) = v[i] * rstd * g4[i]; } }
}

constexpr int N_PHASES = 20;
__global__ void __launch_bounds__(512, 2) mega(Params P) {
    extern __shared__ __attribute__((aligned(16))) unsigned char lds_raw[];
    LAS unsigned char* lds = (LAS unsigned char*)lds_raw;
    cg::grid_group grid = cg::this_grid();
    unsigned* barw = (unsigned*)(P.ws + WS_BAR);
    volatile LAS unsigned* bst = (volatile LAS unsigned*)(lds + 155648);
    if (threadIdx.x < 2) bst[threadIdx.x] = 0u;
    __syncthreads();
    XcdBarrier bar = xcd_barrier_post(barw, bst);
    if (P.ph_hi > 1000) grid.sync();
    int ph = 0;
#ifndef PROBE_KIND
#define PROBE_KIND -1
#endif
#define PHASE(kind, ...) do { if (ph >= P.ph_lo && ph < P.ph_hi) { int nrep_ = ((kind) == PROBE_KIND) ? 2 : 1; asm volatile("" : "+s"(nrep_)); \
        for (int rep_ = 0; rep_ < nrep_; ++rep_) { __VA_ARGS__; if (rep_ + 1 < nrep_) __syncthreads(); } \
        if (ph + 1 < P.ph_hi) xcd_barrier(bar); } ++ph; } while (0)
    PHASE(0, phase0(P, lds));
#pragma unroll 1
    for (int l = 0; l < 2; ++l) {
        const unsigned char* wl = P.ws + (size_t)l * W_LAYER;
        const float* modl = (const float*)(P.ws + WS_MOD) + (size_t)l * 16 * 6144;
        PHASE(1, phase_h<true>(P, l, lds));
        PHASE(2, { EpiP e; e.O = (bf16_t*)(P.ws + WS_A); run_gemm<true>(lds, (const bf16_t*)(P.ws + WS_B), (const bf16_t*)(wl + W_IN), 3072, 1024, e);
                small_gemm<64, 64, 4>(lds, (const bf16_t*)(P.ws + WS_B), (const bf16_t*)(wl + W_IN), 3072, 1024, e); });
        PHASE(3, phase_b1(P, l, lds));
        PHASE(4, phase_scan_sgu(P, l, lds));
        PHASE(10, phase_gnorm(P, l));
        PHASE(5, { EpiRes e; e.base_p = P.in[0]; e.base_s = P.in[1]; e.xb = xb_ptr(P); e.basef32 = l == 0; e.gate = modl + 2048;
                run_gemm<false>(lds, (const bf16_t*)(P.ws + WS_ACT), (const bf16_t*)(wl + W_OUT), 1024, 1024, e);
                small_gemm<32, 32, 4>(lds, (const bf16_t*)(P.ws + WS_ACT), (const bf16_t*)(wl + W_OUT), 1024, 1024, e); });
        PHASE(6, phase_h<false>(P, l, lds));
        PHASE(7, { EpiH e; e.O = (bf16_t*)(P.ws + WS_A); run_gemm<true>(lds, (const bf16_t*)(P.ws + WS_B), (const bf16_t*)(wl + W_UP), 4096, 1024, e);
                small_gemm<64, 64, 4>(lds, (const bf16_t*)(P.ws + WS_B), (const bf16_t*)(wl + W_UP), 4096, 1024, e); });
        PHASE(8, { EpiRes e; e.base_p = P.in[0]; e.base_s = P.in[1]; e.xb = xb_ptr(P); e.basef32 = 0; e.gate = modl + 5120;
                run_gemm<false>(lds, (const bf16_t*)(P.ws + WS_A), (const bf16_t*)(wl + W_DOWN), 1024, 4096, e);
                small_gemm<32, 32, 8>(lds, (const bf16_t*)(P.ws + WS_A), (const bf16_t*)(wl + W_DOWN), 1024, 4096, e); });
    }
    PHASE(9, phase_final(P, bar));
#undef PHASE
}

#ifndef MK_PER_PHASE
#define MK_PER_PHASE 0
#endif
extern "C" void kernel_launch(void* const* d_in, const int* in_sizes, int n_in, void* d_out, int out_size, void* d_ws, size_t ws_size, hipStream_t stream) {
    static int grid = 0;
    if (grid == 0) {
        if (n_in != 22 || (size_t)out_size != O_END || ws_size < WS_END) { fprintf(stderr, "kernel_launch: unexpected shapes: n_in %d out %d ws %zu (need %zu)\n", n_in, out_size, ws_size, (size_t)WS_END); grid = -1; return; }
        int dev = 0, cus = 0, per_cu = 0;
        if (hipGetDevice(&dev) != hipSuccess || hipDeviceGetAttribute(&cus, hipDeviceAttributeMultiprocessorCount, dev) != hipSuccess) { grid = -1; return; }
        if (hipFuncSetAttribute((const void*)mega, hipFuncAttributeMaxDynamicSharedMemorySize, LDS_BYTES) != hipSuccess) { fprintf(stderr, "kernel_launch: hipFuncSetAttribute failed\n"); grid = -1; return; }
        if (hipOccupancyMaxActiveBlocksPerMultiprocessor(&per_cu, (const void*)mega, 512, LDS_BYTES) != hipSuccess || per_cu < 1) { fprintf(stderr, "kernel_launch: occupancy query says %d\n", per_cu); (void)hipGetLastError(); grid = -1; return; }
        if (cus < 256) { fprintf(stderr, "kernel_launch: needs 256 CUs, device has %d\n", cus); grid = -1; return; }
        grid = 256;
    }
    if (grid < 0) return;
    Params p{};
    for (int i = 0; i < 22; ++i) p.in[i] = (const float*)d_in[i];
    p.out = (float*)d_out; p.ws = (unsigned char*)d_ws;
#if MK_PER_PHASE
    for (int ph = 0; ph < N_PHASES; ++ph) { p.ph_lo = ph; p.ph_hi = ph + 1; hipLaunchKernelGGL(mega, dim3(grid), dim3(512), LDS_BYTES, stream, p); }
#else
    p.ph_lo = 0; p.ph_hi = N_PHASES;
    if (hipMemsetAsync((char*)d_ws + WS_BAR, 0, 3456 * 4, stream) != hipSuccess) { fprintf(stderr, "kernel_launch: memset of the barrier words failed\n"); return; }
    void* args[] = {&p};
    const hipError_t e = hipLaunchCooperativeKernel((const void*)mega, dim3(grid), dim3(512), args, LDS_BYTES, stream);
    if (e != hipSuccess) fprintf(stderr, "kernel_launch: cooperative launch failed: %s (grid %d)\n", hipGetErrorString(e), grid);
#endif
}
```

```cpp
#include <hip/hip_runtime.h>
#include <hip/hip_cooperative_groups.h>
#include <cstdio>
#include <cstdint>
namespace cg = cooperative_groups;
namespace pg8 {
#define PG8_LAS __attribute__((address_space(3)))
typedef unsigned short bf16_t;
typedef short bf16x8 __attribute__((ext_vector_type(8)));
typedef float f32x4 __attribute__((ext_vector_type(4)));
typedef unsigned u32x4 __attribute__((ext_vector_type(4)));
constexpr int BM = 256, BK = 64, HALF = 128, HTB = HALF * BK * 2  , STAGE_BYTES = 8 * HTB, NXCD = 8, WGM = 8;

__host__ __device__ __forceinline__ int lds_byte(int r, int c) { const int st = (r >> 4) * 2 + (c >> 5), rr = r & 15, cc = c & 31, ob = rr * 64 + cc * 2; return st * 1024 + (ob ^ (((ob >> 9) & 1) << 5)); }
__host__ __device__ __forceinline__ void stage_rc(int b, int& R, int& C) { const int st = b / 1024, sb = b % 1024, swz = sb ^ (((sb >> 9) & 1) << 5); R = (st >> 1) * 16 + swz / 64; C = (st & 1) * 32 + (swz % 64) / 2; }
__host__ __device__ __forceinline__ int perm32(int rho) { const int n = rho >> 4, i = rho & 15; return 8 * (i >> 2) + 4 * n + (i & 3); }

struct Unit { int pm, pn; };
struct Gemm { const bf16_t* A; const bf16_t* Bt; int M, N, K; };

struct StaticOrder {
    int nM, nN, nwg, G, c;
    __host__ __device__ void init(int M, int N, int G_, int c_) { nM = M / BM; nN = N / BM; nwg = nM * nN; G = G_; c = c_; }
    __host__ __device__ bool next(int i, Unit& u) const {
        const long L = (long)i * G + c; if (L >= nwg) return false;
        int wgid = (int)L; { const int q = nwg / NXCD, r = nwg % NXCD, xcd = wgid % NXCD, off = wgid / NXCD; wgid = (xcd < r ? xcd * (q + 1) : r * (q + 1) + (xcd - r) * q) + off; }
        const int nig = WGM * nN, gid = wgid / nig, fm = gid * WGM, gsz = (nM - fm) < WGM ? (nM - fm) : WGM;
        u.pm = fm + ((wgid % nig) % gsz); u.pn = (wgid % nig) / gsz; return true;
    }
    __device__ __forceinline__ void a_ready(const Unit&) const {}
    __device__ __forceinline__ void done(const Unit&) const {}
};
__device__ __forceinline__ unsigned cvt_pk_bf16(float lo, float hi) { unsigned r; asm volatile("v_cvt_pk_bf16_f32 %0, %1, %2" : "=v"(r) : "v"(lo), "v"(hi)); return r; }
typedef float f32x2 __attribute__((ext_vector_type(2)));
template <class Epi, class Sched, bool ALIGN_EPI = false, bool SP2 = false>
__device__ __forceinline__ void gemm_phase(PG8_LAS unsigned char* lds, const Gemm g, const Sched& S, const Epi& E) {
    int tid_ = threadIdx.x; asm volatile("" : "+v"(tid_));
    const int tid = tid_, wid = __builtin_amdgcn_readfirstlane(tid >> 6), lane = tid & 63, wr = wid >> 2, wc = wid & 3, fr = lane & 15, fq = lane >> 4;
    const int K = g.K, nt = K / BK;
    unsigned voffA[2], voffB[2];
#pragma unroll
    for (int i = 0; i < 2; ++i) { int R, C; stage_rc(tid * 16 + i * 8192, R, C); const int Rb = Epi::PERM ? ((R & ~31) + perm32(R & 31)) : R;
        voffA[i] = (unsigned)(R * K + C) * 2u; voffB[i] = (unsigned)(Rb * K + C) * 2u; }
    const size_t kstep = (size_t)(BK * 2);
    const size_t hstep = (size_t)HALF * K * 2;
    const size_t tstep = 2 * hstep;
    const unsigned ldsw = (unsigned)wid * 1024u;
    const int aoff = lds_byte(wr * 64 + fr, fq * 8), boff = lds_byte(wc * 32 + fr, fq * 8);
#define PG8_SA(b, h) (((b) * 2 + (h)) * HTB)
#define PG8_SB(b, h) ((4 + (b) * 2 + (h)) * HTB)
#define PG8_STAGE(bufoff, gbase, voff) do { _Pragma("unroll") for (int _i = 0; _i < 2; ++_i) \
        __builtin_amdgcn_global_load_lds((const unsigned*)((const char*)(gbase) + (voff)[_i]), (PG8_LAS unsigned*)(lds + (bufoff) + ldsw + _i * 8192), 16, 0, 0); } while (0)
#define PG8_LDA(dst, b, h) do { _Pragma("unroll") for (int m = 0; m < 4; ++m) _Pragma("unroll") for (int k = 0; k < 2; ++k) dst[m][k] = *(const PG8_LAS bf16x8*)(lds + PG8_SA(b, h) + aoff + m * 2048 + k * 1024); } while (0)
#define PG8_LDB(dst, b, h) do { _Pragma("unroll") for (int n = 0; n < 2; ++n) _Pragma("unroll") for (int k = 0; k < 2; ++k) dst[n][k] = *(const PG8_LAS bf16x8*)(lds + PG8_SB(b, h) + boff + n * 2048 + k * 1024); } while (0)
#define PG8_MMA(ai, bj, At, Bt) do { __builtin_amdgcn_s_setprio(1); _Pragma("unroll") for (int m = 0; m < 4; ++m) _Pragma("unroll") for (int n = 0; n < 2; ++n) _Pragma("unroll") for (int k = 0; k < 2; ++k) \
        acc[ai][bj][m][n] = __builtin_amdgcn_mfma_f32_16x16x32_bf16(Bt[n][k], At[m][k], acc[ai][bj][m][n], 0, 0, 0); __builtin_amdgcn_s_setprio(0); } while (0)
#define PG8_WAIT_V(n) asm volatile("s_waitcnt vmcnt(" #n ")" ::: "memory")
#define PG8_WAIT_L(n) asm volatile("s_waitcnt lgkmcnt(" #n ")" ::: "memory")
#define PG8_BAR __builtin_amdgcn_s_barrier()
#define PG8_SCHED __builtin_amdgcn_sched_barrier(0)
    Unit cur, nxt; int ui = 0;
    if (!S.next(0, cur)) return;
    f32x4 acc[2][2][4][2];
#pragma unroll
    for (int a = 0; a < 2; ++a)
#pragma unroll
        for (int b = 0; b < 2; ++b)
#pragma unroll
            for (int m = 0; m < 4; ++m)
#pragma unroll
                for (int n = 0; n < 2; ++n) acc[a][b][m][n] = (f32x4){0.f, 0.f, 0.f, 0.f};
    bf16x8 At[4][2], B0[2][2], B1[2][2];
    const char* cA = (const char*)g.A + (size_t)cur.pm * tstep; const char* cB = (const char*)g.Bt + (size_t)cur.pn * tstep;
    S.a_ready(cur);
    if constexpr (SP2) {
        PG8_STAGE(PG8_SB(0, 0), cB, voffB); PG8_STAGE(PG8_SB(0, 1), cB + hstep, voffB); PG8_STAGE(PG8_SA(0, 0), cA, voffA); PG8_STAGE(PG8_SA(0, 1), cA + hstep, voffA);
        if (wr == 1) PG8_BAR;
        PG8_WAIT_V(2); PG8_BAR;
        PG8_STAGE(PG8_SB(1, 0), cB + kstep, voffB); PG8_STAGE(PG8_SA(1, 0), cA + kstep, voffA); PG8_STAGE(PG8_SB(1, 1), cB + hstep + kstep, voffB);
        PG8_WAIT_V(6); PG8_BAR;
    } else {
        PG8_STAGE(PG8_SB(0, 0), cB, voffB); PG8_STAGE(PG8_SA(0, 0), cA, voffA); PG8_STAGE(PG8_SB(0, 1), cB + hstep, voffB); PG8_STAGE(PG8_SA(0, 1), cA + hstep, voffA);
        if (wr == 1) PG8_BAR;
        PG8_WAIT_V(4); PG8_BAR;
        PG8_STAGE(PG8_SB(1, 0), cB + kstep, voffB); PG8_STAGE(PG8_SA(1, 0), cA + kstep, voffA); PG8_STAGE(PG8_SB(1, 1), cB + hstep + kstep, voffB);
        PG8_WAIT_V(6); PG8_BAR;
    }
    for (;;) {
        const bool has_next = S.next(ui + 1, nxt);
        const char* nA = has_next ? (const char*)g.A + (size_t)nxt.pm * tstep : cA; const char* nB = has_next ? (const char*)g.Bt + (size_t)nxt.pn * tstep : cB;
        for (int t = 0; t < nt; t += 2) {
            const bool last = (t == nt - 2);
            const char* a1 = cA + (size_t)(t + 1) * kstep;
            const char* a2 = last ? nA : cA + (size_t)(t + 2) * kstep; const char* b2 = last ? nB : cB + (size_t)(t + 2) * kstep;
            const char* a3 = a2 + kstep; const char* b3 = b2 + kstep;
            if (last && has_next) S.a_ready(nxt);
            if constexpr (SP2) {
            PG8_LDB(B0, 0, 0); PG8_LDB(B1, 0, 1); PG8_SCHED; PG8_LDA(At, 0, 0); PG8_STAGE(PG8_SA(1, 1), a1 + hstep, voffA);
            PG8_WAIT_V(8); PG8_WAIT_L(0); PG8_BAR; PG8_MMA(0, 0, At, B0); PG8_MMA(0, 1, At, B1); PG8_BAR; PG8_SCHED;
            PG8_LDA(At, 0, 1); PG8_STAGE(PG8_SB(0, 0), b2, voffB); PG8_STAGE(PG8_SB(0, 1), b2 + hstep, voffB); PG8_STAGE(PG8_SA(0, 0), a2, voffA);
            PG8_WAIT_V(8); PG8_WAIT_L(0); PG8_BAR; PG8_MMA(1, 0, At, B0); PG8_MMA(1, 1, At, B1); PG8_BAR; PG8_SCHED;
            PG8_LDB(B0, 1, 0); PG8_LDB(B1, 1, 1); PG8_SCHED; PG8_LDA(At, 1, 0); PG8_STAGE(PG8_SA(0, 1), a2 + hstep, voffA);
            PG8_WAIT_V(8); PG8_WAIT_L(0); PG8_BAR; PG8_MMA(0, 0, At, B0); PG8_MMA(0, 1, At, B1); PG8_BAR; PG8_SCHED;
            PG8_LDA(At, 1, 1); PG8_STAGE(PG8_SB(1, 0), b3, voffB); PG8_STAGE(PG8_SB(1, 1), b3 + hstep, voffB); PG8_STAGE(PG8_SA(1, 0), a3, voffA);
            PG8_WAIT_V(8); PG8_WAIT_L(0); PG8_BAR; PG8_MMA(1, 0, At, B0); PG8_MMA(1, 1, At, B1); PG8_BAR; PG8_SCHED;
            } else {
            PG8_LDB(B0, 0, 0); PG8_SCHED; PG8_LDA(At, 0, 0); PG8_STAGE(PG8_SA(1, 1), a1 + hstep, voffA);
            PG8_WAIT_L(8); PG8_BAR; PG8_WAIT_L(0); PG8_MMA(0, 0, At, B0); PG8_BAR; PG8_SCHED;
            PG8_LDB(B1, 0, 1); PG8_STAGE(PG8_SB(0, 0), b2, voffB);
            PG8_BAR; PG8_WAIT_L(0); PG8_MMA(0, 1, At, B1); PG8_BAR;
            PG8_LDA(At, 0, 1); PG8_STAGE(PG8_SA(0, 0), a2, voffA);
            PG8_BAR; PG8_WAIT_L(0); PG8_MMA(1, 0, At, B0); PG8_BAR; PG8_SCHED;
            PG8_STAGE(PG8_SB(0, 1), b2 + hstep, voffB);
            PG8_WAIT_V(6); PG8_BAR; PG8_MMA(1, 1, At, B1); PG8_BAR;
            PG8_LDB(B0, 1, 0); PG8_SCHED; PG8_LDA(At, 1, 0); PG8_STAGE(PG8_SA(0, 1), a2 + hstep, voffA);
            PG8_WAIT_L(8); PG8_BAR; PG8_WAIT_L(0); PG8_MMA(0, 0, At, B0); PG8_BAR; PG8_SCHED;
            PG8_LDB(B1, 1, 1); PG8_STAGE(PG8_SB(1, 0), b3, voffB);
            PG8_BAR; PG8_WAIT_L(0); PG8_MMA(0, 1, At, B1); PG8_BAR;
            PG8_LDA(At, 1, 1); PG8_STAGE(PG8_SA(1, 0), a3, voffA);
            PG8_BAR; PG8_WAIT_L(0); PG8_MMA(1, 0, At, B0); PG8_BAR; PG8_SCHED;
            PG8_STAGE(PG8_SB(1, 1), b3 + hstep, voffB);
            PG8_WAIT_V(6); PG8_BAR; PG8_MMA(1, 1, At, B1); PG8_BAR;
            }
        }
        if constexpr (ALIGN_EPI) { if (wr == 0) PG8_BAR; }
        if constexpr (!Epi::AFTER_DRAIN) { E(acc, cur, wr, wc, fr, fq); S.done(cur); }
        if (!has_next) break;
#pragma unroll
        for (int a = 0; a < 2; ++a)
#pragma unroll
            for (int b = 0; b < 2; ++b)
#pragma unroll
                for (int m = 0; m < 4; ++m)
#pragma unroll
                    for (int n = 0; n < 2; ++n) acc[a][b][m][n] = (f32x4){0.f, 0.f, 0.f, 0.f};
        cur = nxt; cA = nA; cB = nB; ++ui;
        if constexpr (ALIGN_EPI) { if (wr == 1) PG8_BAR; }
    }
    PG8_WAIT_V(0);
    if constexpr (!ALIGN_EPI) { if (wr == 0) PG8_BAR; }
    PG8_BAR;
    if constexpr (Epi::AFTER_DRAIN) { E.fused(acc, cur, wr, wc, fr, fq, lds, wid, lane); S.done(cur); }
#undef PG8_SA
#undef PG8_SB
#undef PG8_STAGE
#undef PG8_LDA
#undef PG8_LDB
#undef PG8_MMA
#undef PG8_WAIT_V
#undef PG8_WAIT_L
#undef PG8_BAR
#undef PG8_SCHED
}
}


#define LAS __attribute__((address_space(3)))
using pg8::bf16_t; using pg8::bf16x8; using pg8::f32x4;
typedef unsigned u32x2 __attribute__((ext_vector_type(2)));
typedef unsigned u32x4 __attribute__((ext_vector_type(4)));

constexpr int TP = 16384, TS = 256, TT = TP + TS;
constexpr int NSLOT = 1056;
constexpr size_t MiB = 1u << 20;
constexpr size_t W_LAYER = 24 * MiB, W_IN = 0, W_OUT = 6 * MiB, W_UP = 8 * MiB, W_DOWN = 16 * MiB;
constexpr size_t WS_ACT = 48 * MiB;
constexpr size_t WS_A = WS_ACT + (size_t)TT * 1024 * 2;
constexpr size_t WS_UC = WS_A + (size_t)TT * 3072 * 2;
constexpr size_t SLOT16 = (size_t)NSLOT * 8192 * 2;
constexpr size_t WS_WC = WS_UC + SLOT16;
constexpr size_t WS_B = WS_WC + SLOT16;
constexpr size_t WS_QG = WS_B, WS_KGT = WS_QG + SLOT16, WS_ATT = WS_KGT + SLOT16;
constexpr size_t WS_MOD = WS_ATT + (size_t)NSLOT * 4096 * 2;
constexpr size_t WS_BG = WS_MOD + 2 * 16 * 6144 * 4;
constexpr size_t WS_GL = WS_BG + (size_t)TT * 8 * 4;
constexpr size_t WS_BAR = (WS_GL + NSLOT * 4 + 511) / 256 * 256;
constexpr size_t WS_END = WS_BAR + 3456 * 4 + 256;
static_assert(WS_A + (size_t)TT * 4096 * 2 <= WS_B, "hidden overlay");
static_assert(WS_B + (size_t)TT * 1024 * 2 <= WS_ATT, "hbuf overlay");
static_assert(WS_END <= 256 * MiB, "ws");
constexpr size_t O_YS = (size_t)TP * 1024, O_PCONV = O_YS + (size_t)TS * 1024, O_PDELTA = O_PCONV + 2 * 8 * 3 * 1536,
                 O_SCONV = O_PDELTA + 2 * 8 * 4 * 128 * 128, O_SDELTA = O_SCONV + 2 * 8 * 3 * 1536, O_SGUV = O_SDELTA + 2 * 8 * 4 * 128 * 128,
                 O_END = O_SGUV + 2 * 8 * 32 * 512;
constexpr int LDS_BYTES = 156 * 1024;

struct Params { const float* in[22]; float* out; unsigned char* ws; int ph_lo, ph_hi; };

typedef __bf16 hwbf2 __attribute__((ext_vector_type(2)));
typedef float f32x2_t __attribute__((ext_vector_type(2)));
__device__ __forceinline__ unsigned pk2(float lo, float hi) { const f32x2_t v = {lo, hi}; return __builtin_bit_cast(unsigned, __builtin_convertvector(v, hwbf2)); }
__device__ __forceinline__ unsigned short f2bf(float f) { return (unsigned short)(pk2(f, 0.f) & 0xffffu); }
__device__ __forceinline__ float bf2f(unsigned short b) { return __uint_as_float(((unsigned)b) << 16); }
__device__ __forceinline__ float bflo(unsigned w) { return __uint_as_float(w << 16); }
__device__ __forceinline__ float bfhi(unsigned w) { return __uint_as_float(w & 0xffff0000u); }
__device__ __forceinline__ float wave_sum(float v) {
#pragma unroll
    for (int o = 32; o >= 1; o >>= 1) v += __shfl_xor(v, o);
    return v; }
__device__ __forceinline__ float silu_f(float x) { return x * __builtin_amdgcn_rcpf(1.f + __expf(-x)); }
__device__ __forceinline__ float sigmoid_f(float x) { return __builtin_amdgcn_rcpf(1.f + __expf(-x)); }
__device__ __forceinline__ float gelu_tanh(float x) { return x * __builtin_amdgcn_rcpf(1.f + __expf(-1.5957691216f * (x + 0.044715f * x * x * x))); }
__device__ __forceinline__ int row_tb(int r) { return r < TP ? (r >> 11) : 8 + ((r - TP) >> 5); }
__device__ __forceinline__ bf16x8 mk8(unsigned a, unsigned b, unsigned c, unsigned d) { u32x4 v = {a, b, c, d}; return __builtin_bit_cast(bf16x8, v); }
__device__ __forceinline__ int tid_l() { int t = threadIdx.x; asm volatile("" : "+v"(t)); return t; }
__device__ __forceinline__ int bid_l() { int t = blockIdx.x; asm volatile("" : "+s"(t)); return t; }
__device__ __forceinline__ bf16_t* xb_ptr(const Params& P) { return (bf16_t*)((unsigned char*)P.out + (size_t)TT * 2048); }
__device__ __forceinline__ f32x4 bf4(u32x2 t) { return (f32x4){bflo(t.x), bfhi(t.x), bflo(t.y), bfhi(t.y)}; }
#define MFMA16(a, b, c) __builtin_amdgcn_mfma_f32_16x16x32_bf16((a), (b), (c), 0, 0, 0)

struct EpiP {
    static constexpr bool PERM = true, AFTER_DRAIN = false;
    bf16_t* O;
    __device__ __forceinline__ void operator()(const f32x4 (&acc)[2][2][4][2], const pg8::Unit& u, int wr, int wc, int fr, int fq) const {
        const int row0 = u.pm * 256 + wr * 64 + fr, col0 = u.pn * 256 + wc * 32 + 8 * fq; const bool act = u.pn < 4, zact = u.pn >= 10;
#pragma unroll
        for (int ai = 0; ai < 2; ++ai)
#pragma unroll
            for (int m = 0; m < 4; ++m) { bf16_t* rowp = O + (size_t)(row0 + ai * 128 + m * 16) * 3072 + col0;
#pragma unroll
                for (int bj = 0; bj < 2; ++bj) { f32x4 v0 = acc[ai][bj][m][0], v1 = acc[ai][bj][m][1];
                    if (act) {
#pragma unroll
                        for (int j = 0; j < 4; ++j) { v0[j] = gelu_tanh(v0[j]); v1[j] = gelu_tanh(v1[j]); } }
                    if (zact) {
#pragma unroll
                        for (int j = 0; j < 4; ++j) { v0[j] = silu_f(v0[j]); v1[j] = silu_f(v1[j]); } }
                    u32x4 w; w.x = pg8::cvt_pk_bf16(v0[0], v0[1]); w.y = pg8::cvt_pk_bf16(v0[2], v0[3]); w.z = pg8::cvt_pk_bf16(v1[0], v1[1]); w.w = pg8::cvt_pk_bf16(v1[2], v1[3]);
                    *(u32x4*)(rowp + bj * 128) = w; } }
    }
    __device__ __forceinline__ void row8(int r, int c, const float (&v)[8]) const {
        float t[8];
#pragma unroll
        for (int j = 0; j < 8; ++j) t[j] = c < 1024 ? gelu_tanh(v[j]) : (c >= 2560 ? silu_f(v[j]) : v[j]);
        u32x4 w; w.x = pk2(t[0], t[1]); w.y = pk2(t[2], t[3]); w.z = pk2(t[4], t[5]); w.w = pk2(t[6], t[7]);
        *(u32x4*)(O + (size_t)r * 3072 + c) = w; }
};
struct EpiH {
    static constexpr bool PERM = true, AFTER_DRAIN = false;
    bf16_t* O;
    __device__ __forceinline__ void operator()(const f32x4 (&acc)[2][2][4][2], const pg8::Unit& u, int wr, int wc, int fr, int fq) const {
        const int row0 = u.pm * 256 + wr * 64 + fr, col0 = u.pn * 256 + wc * 32 + 8 * fq;
#pragma unroll
        for (int ai = 0; ai < 2; ++ai)
#pragma unroll
            for (int m = 0; m < 4; ++m) { bf16_t* rowp = O + (size_t)(row0 + ai * 128 + m * 16) * 4096 + col0;
#pragma unroll
                for (int bj = 0; bj < 2; ++bj) { f32x4 v0 = acc[ai][bj][m][0], v1 = acc[ai][bj][m][1];
#pragma unroll
                    for (int j = 0; j < 4; ++j) { const float a = fmaxf(v0[j], 0.f), b = fmaxf(v1[j], 0.f); v0[j] = a * a; v1[j] = b * b; }
                    u32x4 w; w.x = pg8::cvt_pk_bf16(v0[0], v0[1]); w.y = pg8::cvt_pk_bf16(v0[2], v0[3]); w.z = pg8::cvt_pk_bf16(v1[0], v1[1]); w.w = pg8::cvt_pk_bf16(v1[2], v1[3]);
                    *(u32x4*)(rowp + bj * 128) = w; } }
    }
    __device__ __forceinline__ void row8(int r, int c, const float (&v)[8]) const {
        float t[8];
#pragma unroll
        for (int j = 0; j < 8; ++j) { const float a = fmaxf(v[j], 0.f); t[j] = a * a; }
        u32x4 w; w.x = pk2(t[0], t[1]); w.y = pk2(t[2], t[3]); w.z = pk2(t[4], t[5]); w.w = pk2(t[6], t[7]);
        *(u32x4*)(O + (size_t)r * 4096 + c) = w; }
};
struct EpiRes {
    static constexpr bool PERM = true, AFTER_DRAIN = false;
    const float* base_p; const float* base_s; bf16_t* xb; bf16_t* xo; const float* gate; int basef32;
    __device__ __forceinline__ void operator()(const f32x4 (&acc)[2][2][4][2], const pg8::Unit& u, int wr, int wc, int fr, int fq) const {
        const int row0 = u.pm * 256 + wr * 64 + fr, col0 = u.pn * 256 + wc * 32 + 8 * fq;
#pragma unroll
        for (int ai = 0; ai < 2; ++ai)
#pragma unroll
            for (int m = 0; m < 4; ++m) { const int r = row0 + ai * 128 + m * 16; const float* gp = gate + row_tb(r) * 6144; bf16_t* xr = xb + (size_t)r * 1024;
#pragma unroll
                for (int bj = 0; bj < 2; ++bj) { const int c = col0 + bj * 128; const f32x4 g0 = *(const f32x4*)(gp + c), g1 = *(const f32x4*)(gp + c + 4); f32x4 b0, b1;
                    if (basef32) { const float* bp = (r < TP) ? base_p + (size_t)r * 1024 : base_s + (size_t)(r - TP) * 1024; b0 = *(const f32x4*)(bp + c); b1 = *(const f32x4*)(bp + c + 4); }
                    else { const u32x4 raw = *(const u32x4*)(xr + c); b0 = bf4((u32x2){raw.x, raw.y}); b1 = bf4((u32x2){raw.z, raw.w}); }
                    const f32x4 x0 = b0 + g0 * acc[ai][bj][m][0], x1 = b1 + g1 * acc[ai][bj][m][1];
                    *(u32x4*)(xo + (size_t)r * 1024 + c) = (u32x4){pk2(x0[0], x0[1]), pk2(x0[2], x0[3]), pk2(x1[0], x1[1]), pk2(x1[2], x1[3])}; } }
    }
    __device__ __forceinline__ void row8(int r, int c, const float (&v)[8]) const {
        const float* gp = gate + row_tb(r) * 6144 + c; bf16_t* xr = xb + (size_t)r * 1024 + c;
        const f32x4 g0 = *(const f32x4*)gp, g1 = *(const f32x4*)(gp + 4); f32x4 b0, b1;
        if (basef32) { const float* bp = base_s + (size_t)(r - TP) * 1024 + c; b0 = *(const f32x4*)bp; b1 = *(const f32x4*)(bp + 4); }
        else { const u32x4 raw = *(const u32x4*)xr; b0 = bf4((u32x2){raw.x, raw.y}); b1 = bf4((u32x2){raw.z, raw.w}); }
        const f32x4 x0 = b0 + g0 * (f32x4){v[0], v[1], v[2], v[3]}, x1 = b1 + g1 * (f32x4){v[4], v[5], v[6], v[7]};
        *(u32x4*)(xo + (size_t)r * 1024 + c) = (u32x4){pk2(x0[0], x0[1]), pk2(x0[2], x0[3]), pk2(x1[0], x1[1]), pk2(x1[2], x1[3])}; }
};
template <bool ALIGN, class Epi> __device__ __forceinline__ void run_gemm(LAS unsigned char* lds, const bf16_t* A, const bf16_t* Bt, int N, int K, const Epi& E) {
    pg8::Gemm g; g.A = A; g.Bt = Bt; g.M = TP; g.N = N; g.K = K;
    pg8::StaticOrder S; S.init(TP, N, (int)gridDim.x, bid_l());
    pg8::gemm_phase<Epi, pg8::StaticOrder, ALIGN, true>(lds, g, S, E);
}
template <int TM, int TN, int UNR, class Epi> __device__ __forceinline__ void small_gemm(LAS unsigned char* lds, const bf16_t* A, const bf16_t* Bt, int N, int K, const Epi& E) {
    constexpr int MT = TM / 16, NT = TN / 16;
    const int tid = tid_l(), lane = tid & 63, wave = tid >> 6, x = lane & 15, kq = lane >> 4;
    const int ntn = N / TN, ntiles = (TS / TM) * ntn, kw = K / 8;
    LAS float* red = (LAS float*)lds;
    for (int t = bid_l(); t < ntiles; t += gridDim.x) {
        const int tm = t / ntn, tn = t - tm * ntn;
        const bf16_t* ap = A + (size_t)(TP + tm * TM + x) * K + wave * kw + kq * 8;
        const bf16_t* bp = Bt + (size_t)(tn * TN + x) * K + wave * kw + kq * 8;
        f32x4 acc[NT][MT];
#pragma unroll
        for (int nt = 0; nt < NT; ++nt)
#pragma unroll
            for (int mt = 0; mt < MT; ++mt) acc[nt][mt] = (f32x4){0.f, 0.f, 0.f, 0.f};
        for (int ks0 = 0; ks0 < kw / 32; ks0 += UNR) {
            bf16x8 af[UNR][MT], bfr[UNR][NT];
#pragma unroll
            for (int j = 0; j < UNR; ++j) {
#pragma unroll
                for (int mt = 0; mt < MT; ++mt) af[j][mt] = *(const bf16x8*)(ap + (size_t)mt * 16 * K + (ks0 + j) * 32);
#pragma unroll
                for (int nt = 0; nt < NT; ++nt) bfr[j][nt] = *(const bf16x8*)(bp + (size_t)nt * 16 * K + (ks0 + j) * 32); }
            __builtin_amdgcn_sched_barrier(0);
#pragma unroll
            for (int j = 0; j < UNR; ++j)
#pragma unroll
                for (int nt = 0; nt < NT; ++nt)
#pragma unroll
                    for (int mt = 0; mt < MT; ++mt) acc[nt][mt] = MFMA16(bfr[j][nt], af[j][mt], acc[nt][mt]);
            __builtin_amdgcn_sched_barrier(0);
        }
#pragma unroll
        for (int nt = 0; nt < NT; ++nt)
#pragma unroll
            for (int mt = 0; mt < MT; ++mt) *(LAS f32x4*)(red + wave * TM * TN + (16 * mt + x) * TN + 16 * nt + kq * 4) = acc[nt][mt];
        __syncthreads();
        if (tid < TM * TN / 8) { const int r = tid / (TN / 8), c8 = (tid % (TN / 8)) * 8; float v[8];
#pragma unroll
            for (int j = 0; j < 8; ++j) v[j] = 0.f;
#pragma unroll
            for (int w = 0; w < 8; ++w) { const f32x4 a = *(const LAS f32x4*)(red + w * TM * TN + r * TN + c8), c = *(const LAS f32x4*)(red + w * TM * TN + r * TN + c8 + 4);
                v[0] += a[0]; v[1] += a[1]; v[2] += a[2]; v[3] += a[3]; v[4] += c[0]; v[5] += c[1]; v[6] += c[2]; v[7] += c[3]; }
            E.row8(TP + tm * TM + r, tn * TN + c8, v); }
        __syncthreads();
    }
}

__device__ __forceinline__ void transpose_tile4(const float* W, int ldw, bf16_t* Bt, int ldb, int k0, int n0, LAS float* tile  ) {
    const int tid = tid_l(), ty = tid >> 6, tx = tid & 63;
    f32x4 v[8];
#pragma unroll
    for (int i = 0; i < 8; ++i) v[i] = *(const f32x4*)(W + (size_t)(k0 + ty + 8 * i) * ldw + n0 + tx * 4);
#pragma unroll
    for (int i = 0; i < 8; ++i) { const int k = ty + 8 * i; tile[k * 261 + tx * 4 + 0] = v[i][0]; tile[k * 261 + tx * 4 + 1] = v[i][1]; tile[k * 261 + tx * 4 + 2] = v[i][2]; tile[k * 261 + tx * 4 + 3] = v[i][3]; }
    __syncthreads();
#pragma unroll
    for (int i = 0; i < 4; ++i) { const int n = (tid >> 3) + 64 * i, kq = tid & 7; u32x4 w;
        w.x = pk2(tile[(kq * 8 + 0) * 261 + n], tile[(kq * 8 + 1) * 261 + n]); w.y = pk2(tile[(kq * 8 + 2) * 261 + n], tile[(kq * 8 + 3) * 261 + n]);
        w.z = pk2(tile[(kq * 8 + 4) * 261 + n], tile[(kq * 8 + 5) * 261 + n]); w.w = pk2(tile[(kq * 8 + 6) * 261 + n], tile[(kq * 8 + 7) * 261 + n]);
        *(u32x4*)(Bt + (size_t)(n0 + n) * ldb + k0 + kq * 8) = w; }
    __syncthreads();
}
__device__ __forceinline__ void phase0(const Params& P, LAS unsigned char* lds) {
    const int tid = tid_l(), lane = tid & 63, wave = tid >> 6, G = gridDim.x, bid = bid_l();
    float* mod = (float*)(P.ws + WS_MOD);
    if (bid < 192) {
        LAS float* cs = (LAS float*)lds;
        LAS float* red = (LAS float*)(lds + 65536);
        for (int i = tid; i < 16384; i += 512) { const int tb = i >> 10, k = i & 1023; const float c = tb < 8 ? P.in[2][tb * 1024 + k] : P.in[3][(tb - 8) * 1024 + k]; cs[k * 16 + tb] = silu_f(c); }
        __syncthreads();
        for (int item = bid; item < 192; item += G) {
            const int l = item / 96, cgp = item % 96, j = cgp * 64 + lane;
            const float* wp = P.in[6] + ((size_t)l * 1024 + wave * 128) * 6144 + j;
            float acc[16];
#pragma unroll
            for (int t = 0; t < 16; ++t) acc[t] = 0.f;
#pragma unroll 16
            for (int kk = 0; kk < 128; ++kk) { const float wv = wp[(size_t)kk * 6144]; const LAS f32x4* c4 = (const LAS f32x4*)(cs + (wave * 128 + kk) * 16);
#pragma unroll
                for (int q = 0; q < 4; ++q) { const f32x4 cv = c4[q]; acc[4 * q + 0] += cv[0] * wv; acc[4 * q + 1] += cv[1] * wv; acc[4 * q + 2] += cv[2] * wv; acc[4 * q + 3] += cv[3] * wv; } }
#pragma unroll
            for (int t = 0; t < 16; ++t) red[(wave * 16 + t) * 64 + lane] = acc[t];
            __syncthreads();
            for (int o = tid; o < 1024; o += 512) { const int tb = o >> 6, ln = o & 63; float s = P.in[7][l * 6144 + cgp * 64 + ln];
#pragma unroll
                for (int w = 0; w < 8; ++w) s += red[(w * 16 + tb) * 64 + ln];
                mod[(size_t)(l * 16 + tb) * 6144 + cgp * 64 + ln] = s; }
            __syncthreads();
        }
    }
    __syncthreads();
    LAS float* tile = (LAS float*)lds;
    for (int it = bid; it < 1536; it += G) {
        const int l = it / 768; int r = it % 768; const float* W; int ldw, K, kt, nt; bf16_t* Bt;
        if (r < 192) { W = P.in[10] + (size_t)l * 1024 * 3080; ldw = 3080; K = 1024; Bt = (bf16_t*)(P.ws + l * W_LAYER + W_IN); kt = r / 12; nt = r % 12; }
        else if (r < 256) { r -= 192; W = P.in[18] + (size_t)l * 1024 * 1024; ldw = 1024; K = 1024; Bt = (bf16_t*)(P.ws + l * W_LAYER + W_OUT); kt = r / 4; nt = r % 4; }
        else if (r < 512) { r -= 256; W = P.in[19] + (size_t)l * 1024 * 4096; ldw = 4096; K = 1024; Bt = (bf16_t*)(P.ws + l * W_LAYER + W_UP); kt = r / 16; nt = r % 16; }
        else { r -= 512; W = P.in[20] + (size_t)l * 4096 * 1024; ldw = 1024; K = 4096; Bt = (bf16_t*)(P.ws + l * W_LAYER + W_DOWN); kt = r / 4; nt = r % 4; }
        transpose_tile4(W, ldw, Bt, K, kt * 64, nt * 256, tile);
    }
}

template <bool MIX> __device__ __forceinline__ void phase_h(const Params& P, int l, LAS unsigned char* lds) {
    const int tid = tid_l(), lane = tid & 63, wave = tid >> 6;
    const float* gamma = (MIX ? P.in[8] : P.in[9]) + l * 1024;
    const float* mod = (const float*)(P.ws + WS_MOD) + (size_t)l * 16 * 6144;
    const int shoff = MIX ? 0 : 3072, scoff = MIX ? 1024 : 4096;
    bf16_t* hbuf = (bf16_t*)(P.ws + WS_B);
    float* bg = (float*)(P.ws + WS_BG);
    const float* wab = P.in[10] + (size_t)l * 1024 * 3080 + 3072;
    LAS float* wT = (LAS float*)lds;
    if (MIX) {
#pragma unroll
        for (int i = 0; i < 2; ++i) { const int j = tid + 512 * i; const f32x4 w0 = *(const f32x4*)(wab + (size_t)j * 3080), w1 = *(const f32x4*)(wab + (size_t)j * 3080 + 4);
            wT[j] = w0[0]; wT[1024 + j] = w0[1]; wT[2048 + j] = w0[2]; wT[3072 + j] = w0[3]; wT[4096 + j] = w1[0]; wT[5120 + j] = w1[1]; wT[6144 + j] = w1[2]; wT[7168 + j] = w1[3]; }
        __syncthreads();
    }
    const int gw = bid_l() * 8 + wave;
    const bf16_t* xbp = xb_ptr(P);
#define LOADROW(dst, r_) do { if (MIX && l == 0) { const float* xr_ = (r_) < TP ? P.in[0] + (size_t)(r_) * 1024 : P.in[1] + (size_t)((r_) - TP) * 1024; \
            _Pragma("unroll") for (int i_ = 0; i_ < 4; ++i_) dst[i_] = *(const f32x4*)(xr_ + lane * 4 + 256 * i_); } \
        else { const bf16_t* xr_ = xbp + (size_t)(r_) * 1024; _Pragma("unroll") for (int i_ = 0; i_ < 4; ++i_) dst[i_] = bf4(*(const u32x2*)(xr_ + lane * 4 + 256 * i_)); } } while (0)
#define LOAD_MOD(tb_) do { const float* mp_ = mod + (tb_) * 6144; _Pragma("unroll") for (int i_ = 0; i_ < 4; ++i_) { const int j_ = lane * 4 + 256 * i_; \
        const f32x4 g4_ = *(const f32x4*)(gamma + j_), sc4_ = *(const f32x4*)(mp_ + scoff + j_); csv[i_] = g4_ * (sc4_ + 1.f); shv[i_] = *(const f32x4*)(mp_ + shoff + j_); } } while (0)
    if (gw * 8 >= TP) return;
    f32x4 csv[4], shv[4], v[4];
    LOADROW(v, gw * 8);
    LOAD_MOD((gw * 8) >> 11);
    const int nrows = gw < TS ? 9 : 8;
    for (int it = 0; it < nrows; ++it) {
        const int r = it < 8 ? gw * 8 + it : TP + gw;
        f32x4 vnx[4];
        if (it + 1 < nrows) LOADROW(vnx, (it + 1 < 8 ? gw * 8 + it + 1 : TP + gw));
        if (it == 8) LOAD_MOD(8 + (gw >> 5));
        float ss = 0.f;
#pragma unroll
        for (int i = 0; i < 4; ++i) ss += v[i][0] * v[i][0] + v[i][1] * v[i][1] + v[i][2] * v[i][2] + v[i][3] * v[i][3];
        ss = wave_sum(ss);
        const float rstd = rsqrtf(ss * (1.f / 1024.f) + 1e-6f);
        float ab[8];
#pragma unroll
        for (int e = 0; e < 8; ++e) ab[e] = 0.f;
#pragma unroll
        for (int i = 0; i < 4; ++i) { const int j = lane * 4 + 256 * i;
            const f32x4 hv = v[i] * rstd * csv[i] + shv[i];
            u32x2 w; w.x = pk2(hv[0], hv[1]); w.y = pk2(hv[2], hv[3]);
            *(u32x2*)(hbuf + (size_t)r * 1024 + j) = w;
            if (MIX) {
#pragma unroll
                for (int c = 0; c < 8; ++c) { const f32x4 w4 = *(const LAS f32x4*)(wT + c * 1024 + j); ab[c] += hv[0] * w4[0] + hv[1] * w4[1] + hv[2] * w4[2] + hv[3] * w4[3]; }
                __builtin_amdgcn_sched_barrier(0); }
        }
        if (MIX) {
            const bool h1 = lane & 32, h2 = lane & 16, h3 = lane & 8;
            float k4[4], k2[2];
#pragma unroll
            for (int i = 0; i < 4; ++i) { const float send = h1 ? ab[i] : ab[4 + i]; k4[i] = (h1 ? ab[4 + i] : ab[i]) + __shfl_xor(send, 32); }
#pragma unroll
            for (int i = 0; i < 2; ++i) { const float send = h2 ? k4[i] : k4[2 + i]; k2[i] = (h2 ? k4[2 + i] : k4[i]) + __shfl_xor(send, 16); }
            float k1 = (h3 ? k2[1] : k2[0]) + __shfl_xor(h3 ? k2[0] : k2[1], 8);
            k1 += __shfl_xor(k1, 4); k1 += __shfl_xor(k1, 2); k1 += __shfl_xor(k1, 1);
            if ((lane & 7) == 0) { const int idx = lane >> 3, h = idx & 3;
                if (idx < 4) bg[(size_t)r * 8 + h] = sigmoid_f(k1);
                else { const float xx = k1 + P.in[15][l * 4 + h]; const float sp = xx > 20.f ? xx : log1pf(expf(xx)); bg[(size_t)r * 8 + 4 + h] = -expf(P.in[16][l * 4 + h]) * sp; } }
        }
#pragma unroll
        for (int i = 0; i < 4; ++i) v[i] = vnx[i];
    }
#undef LOADROW
#undef LOAD_MOD
}

template <int C> struct B1Raw { static constexpr int NCH = (C + 3) * 48, NB = (NCH + 511) / 512; };
template <int C> __device__ __forceinline__ void b1_issue(const Params& P, int l, int it, int tid, u32x4 (&rv)[B1Raw<C>::NB]) {
    const bool sample = it >= 1024; const int bh = sample ? it - 1024 : it >> 5, ci = sample ? 0 : it & 31, b = bh >> 2, h = bh & 3;
    const int row0 = sample ? TP + b * 32 : b * 2048 + ci * 64; const bool first = ci == 0;
    const bf16_t* p = (const bf16_t*)(P.ws + WS_A);
#pragma unroll
    for (int i = 0; i < B1Raw<C>::NB; ++i) { const int idx = tid + 512 * i; rv[i] = (u32x4){0u, 0u, 0u, 0u};
        if (idx < B1Raw<C>::NCH) { const int rr = idx / 48, cc = idx - rr * 48, tt = rr - 3, ch = (cc >> 4) * 512 + h * 128 + (cc & 15) * 8;
            if (tt >= 0 || !first) rv[i] = *(const u32x4*)(p + (size_t)(row0 + tt) * 3072 + 1024 + ch);
            else if (sample) { const float* sp = P.in[4] + ((size_t)(l * 8 + b) * 3 + rr) * 1536 + ch; const f32x4 a = *(const f32x4*)sp, c4 = *(const f32x4*)(sp + 4);
                rv[i] = (u32x4){pk2(a[0], a[1]), pk2(a[2], a[3]), pk2(c4[0], c4[1]), pk2(c4[2], c4[3])}; } } }
}
template <int C> __device__ __forceinline__ void b1_item(const Params& P, int l, int it, int nxt, u32x4 (&rv)[B1Raw<C>::NB], LAS unsigned char* lds) {
    constexpr int NT = C / 16;
    const int tid = tid_l(), lane = tid & 63, wave = tid >> 6;
    const bool sample = it >= 1024; const int slot = it, bh = sample ? it - 1024 : it >> 5, ci = sample ? 0 : it & 31, b = bh >> 2, h = bh & 3;
    const int row0 = sample ? TP + b * 32 : b * 2048 + ci * 64; const bool last = sample || ci == 31;
    LAS float* F0 = (LAS float*)lds;
    LAS float* F1 = (LAS float*)(lds + 33792);
    LAS float* F2 = (LAS float*)(lds + 67584);
    LAS bf16_t* QB = (LAS bf16_t*)(lds + 101376);
    LAS bf16_t* KB = (LAS bf16_t*)(lds + 118784);
    LAS bf16_t* KBB = (LAS bf16_t*)(lds + 136192);
    LAS float* rn = (LAS float*)(lds + 153600);
    LAS float* betas = rn + 128;
    LAS float* gcs = betas + 64;
    LAS float* egs = gcs + 64;
    LAS float* egls = egs + 64;
    const float* bg = (const float*)(P.ws + WS_BG);
    bf16_t* UC = (bf16_t*)(P.ws + WS_UC) + (size_t)slot * 8192; bf16_t* WC = (bf16_t*)(P.ws + WS_WC) + (size_t)slot * 8192;
    bf16_t* QG = (bf16_t*)(P.ws + WS_QG) + (size_t)slot * 8192; bf16_t* KGT = (bf16_t*)(P.ws + WS_KGT) + (size_t)slot * 8192;
    bf16_t* ATT = (bf16_t*)(P.ws + WS_ATT) + (size_t)slot * 4096;
    LAS bf16_t* RAW = QB;
#pragma unroll
    for (int i = 0; i < B1Raw<C>::NB; ++i) { const int idx = tid + 512 * i; if (idx < B1Raw<C>::NCH) *(LAS u32x4*)(RAW + idx * 8) = rv[i]; }
    __syncthreads();
    if (nxt >= 0) b1_issue<C>(P, l, nxt, tid, rv);
    if (tid < 384) {
        const int c = tid, which = c >> 7, d = c & 127, ch = which * 512 + h * 128 + d;
        const float* cw = P.in[14] + (size_t)l * 4 * 1536 + ch;
        const float w0 = cw[0], w1 = cw[1536], w2 = cw[3072], w3 = cw[4608];
        LAS float* F = which == 0 ? F0 : (which == 1 ? F1 : F2);
        float x0 = bf2f(RAW[c]), x1 = bf2f(RAW[384 + c]), x2 = bf2f(RAW[768 + c]);
#pragma unroll 8
        for (int t = 0; t < C; ++t) { const float x3 = bf2f(RAW[(t + 3) * 384 + c]); F[t * 132 + d] = silu_f(w0 * x0 + w1 * x1 + w2 * x2 + w3 * x3); x0 = x1; x1 = x2; x2 = x3; }
        if (last) { float* oc = P.out + (sample ? O_SCONV : O_PCONV) + (size_t)(l * 8 + b) * 3 * 1536;
            oc[ch] = x0; oc[1536 + ch] = x1; oc[3072 + ch] = x2; }
    } else if (wave == 6) {
        float gv = lane < C ? bg[(size_t)(row0 + lane) * 8 + 4 + h] : 0.f;
#pragma unroll
        for (int dd = 1; dd < 64; dd <<= 1) { const float n = __shfl_up(gv, dd); if (lane >= dd) gv += n; }
        const float gl_ = __shfl(gv, C - 1);
        if (lane < C) { gcs[lane] = gv; betas[lane] = bg[(size_t)(row0 + lane) * 8 + h]; egs[lane] = __expf(gv); egls[lane] = __expf(gl_ - gv); }
        if (lane == 0) ((float*)(P.ws + WS_GL))[slot] = __expf(gl_);
    }
    __syncthreads();
#pragma unroll
    for (int i = 0; i < (2 * C * 8) / 512; ++i) { const int idx = tid + 512 * i, ar = idx >> 3, part = idx & 7; const LAS float* src = (ar < C ? F0 + ar * 132 : F1 + (ar - C) * 132) + part * 16; float ss = 0.f;
#pragma unroll
        for (int j = 0; j < 4; ++j) { const f32x4 v = *(const LAS f32x4*)(src + 4 * j); ss += v[0] * v[0] + v[1] * v[1] + v[2] * v[2] + v[3] * v[3]; }
        ss += __shfl_xor(ss, 1); ss += __shfl_xor(ss, 2); ss += __shfl_xor(ss, 4);
        if (part == 0) rn[ar] = rsqrtf(ss + 1e-6f) * (ar < C ? 0.08838834764831845f : 1.f); }
    __syncthreads();
#pragma unroll
    for (int i = 0; i < (C * 32) / 512; ++i) { const int idx = tid + 512 * i, t = idx >> 5, d = (idx & 31) * 4;
        const f32x4 q4 = *(const LAS f32x4*)(F0 + t * 132 + d), k4 = *(const LAS f32x4*)(F1 + t * 132 + d), v4 = *(const LAS f32x4*)(F2 + t * 132 + d);
        const float rq = rn[t], rk = rn[C + t], bt = betas[t], eg = egs[t];
        const f32x4 qn = q4 * rq, kn = k4 * rk, kbt = kn * bt;
        *(LAS u32x2*)(QB + t * 136 + d) = (u32x2){pk2(qn[0], qn[1]), pk2(qn[2], qn[3])};
        *(LAS u32x2*)(KB + t * 136 + d) = (u32x2){pk2(kn[0], kn[1]), pk2(kn[2], kn[3])};
        *(LAS u32x2*)(KBB + t * 136 + d) = (u32x2){pk2(kbt[0], kbt[1]), pk2(kbt[2], kbt[3])};
        const f32x4 qe = qn * eg; *(u32x2*)(QG + t * 128 + d) = (u32x2){pk2(qe[0], qe[1]), pk2(qe[2], qe[3])};
        *(LAS f32x4*)(F0 + t * 132 + d) = kbt * eg; *(LAS f32x4*)(F2 + t * 132 + d) = v4 * bt; }
#pragma unroll
    for (int i = 0; i < (C * 16) / 512; ++i) { const int idx = tid + 512 * i, d = idx & 127, tg = idx >> 7; float kv[8];
#pragma unroll
        for (int j = 0; j < 8; ++j) { const int t = tg * 8 + j; kv[j] = F1[t * 132 + d] * rn[C + t] * egls[t]; }
        *(u32x4*)(KGT + d * 64 + tg * 8) = (u32x4){pk2(kv[0], kv[1]), pk2(kv[2], kv[3]), pk2(kv[4], kv[5]), pk2(kv[6], kv[7])}; }
    __syncthreads();
    LAS float* AdT = F1;
    LAS bf16_t* Abf = (LAS bf16_t*)(lds + 33792 + 4352);
    LAS float* UL = (LAS float*)(lds + 33792 + 13568);
    if (wave < 2 * NT) {
        const int prod = wave / NT, ti = wave % NT, m = lane & 15, kq = lane >> 4;
        const LAS bf16_t* Asrc = prod == 0 ? KBB : QB;
        for (int tj = 0; tj < NT; ++tj) {
            if (prod == 0 && tj > ti) break;
            f32x4 acc = {0.f, 0.f, 0.f, 0.f};
            if (tj <= ti) {
#pragma unroll
                for (int s = 0; s < 4; ++s) { const bf16x8 a = *(const LAS bf16x8*)(Asrc + (16 * ti + m) * 136 + 32 * s + kq * 8), bb = *(const LAS bf16x8*)(KB + (16 * tj + m) * 136 + 32 * s + kq * 8);
                    acc = MFMA16(a, bb, acc); }
            }
            const int j = 16 * tj + m; const float gj = gcs[j];
#pragma unroll
            for (int r = 0; r < 4; ++r) { const int i = 16 * ti + kq * 4 + r; const float dec = __expf(fminf(gcs[i] - gj, 0.f));
                if (prod == 0) { const float a = (i > j) ? acc[r] * dec : 0.f;
                    if (tj == ti) AdT[(ti * 16 + m) * 16 + kq * 4 + r] = a; else Abf[i * 72 + j] = f2bf(a); }
                else ATT[i * 64 + j] = f2bf((i >= j) ? acc[r] * dec : 0.f); }
        }
    }
    __syncthreads();
    {
        LAS bf16_t* XT = QB;
        const int c = tid & 255; const LAS float* rhs = (c < 128) ? (F2 + c) : (F0 + (c - 128));
        bf16_t* dst = ((c < 128) ? UC : WC) + (c & 127);
        int zoff; asm volatile("v_mov_b32 %0, 0" : "=v"(zoff));
        const LAS float* Az = AdT + zoff * 4;
        const int m = lane & 15, kq = lane >> 4;
#pragma unroll
        for (int bk = 0; bk < NT; ++bk) {
            if (bk > 0) {
#pragma unroll
                for (int cti = 0; cti < 2; ++cti) { const int ct = wave * 2 + cti; f32x4 acc = {0.f, 0.f, 0.f, 0.f};
#pragma unroll
                    for (int s = 0; s < (bk + 1) / 2; ++s) { const bool on = (32 * s + kq * 8) < 16 * bk;
                        u32x4 xa = *(const LAS u32x4*)(XT + (16 * ct + m) * 72 + 32 * s + kq * 8), ab = *(const LAS u32x4*)(Abf + (16 * bk + m) * 72 + 32 * s + kq * 8);
                        if (!on) { xa = (u32x4){0u, 0u, 0u, 0u}; ab = (u32x4){0u, 0u, 0u, 0u}; }
                        acc = MFMA16(__builtin_bit_cast(bf16x8, xa), __builtin_bit_cast(bf16x8, ab), acc); }
                    *(LAS f32x4*)(UL + m * 260 + 16 * ct + kq * 4) = acc; }
                __syncthreads();
            }
            if (tid < 256) {
                float x[16];
#pragma unroll
                for (int i = 0; i < 16; ++i) x[i] = rhs[(16 * bk + i) * 132] - (bk > 0 ? UL[i * 260 + c] : 0.f);
#pragma unroll
                for (int j = 0; j < 15; ++j)
#pragma unroll
                    for (int i = j + 1; i < 16; ++i) x[i] -= Az[(bk * 16 + j) * 16 + i] * x[j];
                const u32x4 w0 = {pk2(x[0], x[1]), pk2(x[2], x[3]), pk2(x[4], x[5]), pk2(x[6], x[7])}, w1 = {pk2(x[8], x[9]), pk2(x[10], x[11]), pk2(x[12], x[13]), pk2(x[14], x[15])};
                *(LAS u32x4*)(XT + c * 72 + 16 * bk) = w0; *(LAS u32x4*)(XT + c * 72 + 16 * bk + 8) = w1;
                if (c < 128) {
                    bf16_t* uf = UC + ((((c >> 4) * 4 + bk) * 64) + (c & 15)) * 4;
                    *(u32x2*)(uf) = (u32x2){w0[0], w0[1]}; *(u32x2*)(uf + 64) = (u32x2){w0[2], w0[3]}; *(u32x2*)(uf + 128) = (u32x2){w1[0], w1[1]}; *(u32x2*)(uf + 192) = (u32x2){w1[2], w1[3]};
                } else {
#pragma unroll
                    for (int i = 0; i < 4; ++i) { dst[(16 * bk + 2 * i) * 128] = (bf16_t)(w0[i] & 0xffffu); dst[(16 * bk + 2 * i + 1) * 128] = (bf16_t)(w0[i] >> 16);
                        dst[(16 * bk + 8 + 2 * i) * 128] = (bf16_t)(w1[i] & 0xffffu); dst[(16 * bk + 8 + 2 * i + 1) * 128] = (bf16_t)(w1[i] >> 16); } }
            }
            __syncthreads();
        }
    }
}
__device__ __forceinline__ void phase_b1(const Params& P, int l, LAS unsigned char* lds) {
    const int tid = tid_l(), G = gridDim.x; int it = bid_l();
    {
        u32x4 rv[B1Raw<64>::NB];
        if (it < 1024) b1_issue<64>(P, l, it, tid, rv);
        for (; it < 1024; it += G) { const int nx = it + G; b1_item<64>(P, l, it, nx < 1024 ? nx : -1, rv, lds); }
    }
    for (; it < NSLOT; it += G) { u32x4 rs[B1Raw<32>::NB]; b1_issue<32>(P, l, it, tid, rs); b1_item<32>(P, l, it, -1, rs, lds); }
}

__device__ __forceinline__ bf16x8 ldA(const LAS bf16_t* X, int ld, int row, int s, int kq) {
    const u32x2 lo = *(const LAS u32x2*)(X + row * ld + 32 * s + kq * 4), hi = *(const LAS u32x2*)(X + row * ld + 32 * s + 16 + kq * 4);
    return mk8(lo.x, lo.y, hi.x, hi.y); }
__device__ __forceinline__ bf16x8 packB(const f32x4& a, const f32x4& b) { return mk8(pk2(a[0], a[1]), pk2(a[2], a[3]), pk2(b[0], b[1]), pk2(b[2], b[3])); }
template <int C> __device__ __forceinline__ void scan_job(const Params& P, int l, int bh, int q, bool sample, LAS unsigned char* lds) {
    constexpr int MT = C / 16, KS = C / 32, NB3 = C / 32, BUF = 62464;
    const int tid = tid_l(), lane = tid & 63, wave = tid >> 6, m = lane & 15, kq = lane >> 4, b = bh >> 2, h = bh & 3;
    const bool active = wave < 2; const int ct = q * 2 + (wave & 1), vcol = ct * 16 + m;
    bf16_t* mixcat = (bf16_t*)(P.ws + WS_ACT);
    f32x4 S[8];
    if (sample && active) { const float* sd = P.in[5] + ((size_t)(l * 8 + b) * 4 + h) * 16384;
#pragma unroll
        for (int kt = 0; kt < 8; ++kt)
#pragma unroll
            for (int r = 0; r < 4; ++r) S[kt][r] = sd[(16 * kt + kq * 4 + r) * 128 + vcol];
    } else {
#pragma unroll
        for (int kt = 0; kt < 8; ++kt) S[kt] = (f32x4){0.f, 0.f, 0.f, 0.f};
    }
    const int nch = sample ? 1 : 32;
    u32x4 pfW[NB3], pfQ[NB3], pfA, pfK[2]; float glp;
#define SCAN_ISSUE(ci_) do { const int slot_ = sample ? 1024 + bh : bh * 32 + (ci_); \
        const bf16_t* gWC = (const bf16_t*)(P.ws + WS_WC) + (size_t)slot_ * 8192; const bf16_t* gQG = (const bf16_t*)(P.ws + WS_QG) + (size_t)slot_ * 8192; \
        const bf16_t* gKG = (const bf16_t*)(P.ws + WS_KGT) + (size_t)slot_ * 8192; \
        const bf16_t* gAT = (const bf16_t*)(P.ws + WS_ATT) + (size_t)slot_ * 4096; \
        _Pragma("unroll") for (int i_ = 0; i_ < NB3; ++i_) { const int idx_ = tid + 512 * i_, r_ = idx_ >> 4, c8_ = (idx_ & 15) * 8; \
            pfW[i_] = *(const u32x4*)(gWC + r_ * 128 + c8_); pfQ[i_] = *(const u32x4*)(gQG + r_ * 128 + c8_); } \
        if (tid < C * 8) pfA = *(const u32x4*)(gAT + (tid >> 3) * 64 + (tid & 7) * 8); \
        _Pragma("unroll") for (int i_ = 0; i_ < 2; ++i_) { const int idx_ = tid + 512 * i_; pfK[i_] = *(const u32x4*)(gKG + (idx_ >> 3) * 64 + (idx_ & 7) * 8); } \
        glp = ((const float*)(P.ws + WS_GL))[slot_]; } while (0)
#define U_ISSUE(ci_, dst_) do { if (active) { const bf16_t* gUC_ = (const bf16_t*)(P.ws + WS_UC) + (size_t)(sample ? 1024 + bh : bh * 32 + (ci_)) * 8192; \
        _Pragma("unroll") for (int mt_ = 0; mt_ < MT; ++mt_) dst_[mt_] = *(const u32x2*)(gUC_ + ((ct * 4 + mt_) * 64 + lane) * 4); } } while (0)
#define SCAN_STORE(par_) do { LAS bf16_t* W_ = (LAS bf16_t*)(lds + (par_) * BUF); LAS bf16_t* Q_ = (LAS bf16_t*)(lds + (par_) * BUF + 17408); \
        LAS bf16_t* A_ = (LAS bf16_t*)(lds + (par_) * BUF + 34816); LAS bf16_t* K_ = (LAS bf16_t*)(lds + (par_) * BUF + 44032); \
        _Pragma("unroll") for (int i_ = 0; i_ < NB3; ++i_) { const int idx_ = tid + 512 * i_, r_ = idx_ >> 4, c8_ = (idx_ & 15) * 8; \
            *(LAS u32x4*)(W_ + r_ * 136 + c8_) = pfW[i_]; *(LAS u32x4*)(Q_ + r_ * 136 + c8_) = pfQ[i_]; } \
        if (tid < C * 8) *(LAS u32x4*)(A_ + (tid >> 3) * 72 + (tid & 7) * 8) = pfA; \
        _Pragma("unroll") for (int i_ = 0; i_ < 2; ++i_) { const int idx_ = tid + 512 * i_; *(LAS u32x4*)(K_ + (idx_ >> 3) * 72 + (idx_ & 7) * 8) = pfK[i_]; } } while (0)
    u32x2 uc[MT], un[MT]; float gl, gln = 0.f;
#pragma unroll
    for (int mt = 0; mt < MT; ++mt) { uc[mt] = (u32x2){0u, 0u}; un[mt] = (u32x2){0u, 0u}; }
    SCAN_ISSUE(0);
    U_ISSUE(0, uc);
    SCAN_STORE(0);
    gl = glp;
    if (nch > 1) SCAN_ISSUE(1);
    __syncthreads();
    for (int ci = 0; ci < nch; ++ci) {
        const int par = ci & 1, row0 = sample ? TP + b * 32 : b * 2048 + ci * 64;
        if (ci + 1 < nch) {
            U_ISSUE(ci + 1, un);
            SCAN_STORE(par ^ 1);
            gln = glp;
            if (ci + 2 < nch) SCAN_ISSUE(ci + 2);
        }
        if (active) {
            const LAS bf16_t* WCs = (const LAS bf16_t*)(lds + par * BUF); const LAS bf16_t* QGs = (const LAS bf16_t*)(lds + par * BUF + 17408);
            const LAS bf16_t* ATs = (const LAS bf16_t*)(lds + par * BUF + 34816); const LAS bf16_t* KGs = (const LAS bf16_t*)(lds + par * BUF + 44032);
            bf16x8 Sb[4];
#pragma unroll
            for (int s = 0; s < 4; ++s) Sb[s] = packB(S[2 * s], S[2 * s + 1]);
            f32x4 vn[MT], oa[MT];
#pragma unroll
            for (int mt = 0; mt < MT; ++mt) { oa[mt] = (f32x4){0.f, 0.f, 0.f, 0.f};
                vn[mt] = (f32x4){-bflo(uc[mt].x), -bfhi(uc[mt].x), -bflo(uc[mt].y), -bfhi(uc[mt].y)}; }
            bf16x8 f0[4], f1[4];
#define SCAN_SB() __builtin_amdgcn_sched_barrier(0)
#define LD_ROWS(dst, X, ld, s_) _Pragma("unroll") for (int mt = 0; mt < MT; ++mt) dst[mt] = ldA(X, ld, 16 * mt + m, (s_), kq);
#define LD_KT(dst, s_, k0_) _Pragma("unroll") for (int kt = 0; kt < 4; ++kt) dst[kt] = ldA(KGs, 72, 16 * ((k0_) + kt) + m, (s_), kq);
#define MM_ROWS(acc, src, bop) _Pragma("unroll") for (int mt = 0; mt < MT; ++mt) acc[mt] = MFMA16(src[mt], (bop), acc[mt]);
#define MM_KT(src, bop, k0_) _Pragma("unroll") for (int kt = 0; kt < 4; ++kt) S[(k0_) + kt] = MFMA16(src[kt], (bop), S[(k0_) + kt]);
            LD_ROWS(f0, WCs, 136, 0); LD_ROWS(f1, WCs, 136, 1); SCAN_SB();
            MM_ROWS(vn, f0, Sb[0]); LD_ROWS(f0, WCs, 136, 2); SCAN_SB();
            MM_ROWS(vn, f1, Sb[1]); LD_ROWS(f1, WCs, 136, 3); SCAN_SB();
            MM_ROWS(vn, f0, Sb[2]); LD_ROWS(f0, QGs, 136, 0); SCAN_SB();
            MM_ROWS(vn, f1, Sb[3]); LD_ROWS(f1, QGs, 136, 1); SCAN_SB();
            MM_ROWS(oa, f0, Sb[0]); LD_ROWS(f0, QGs, 136, 2); SCAN_SB();
            MM_ROWS(oa, f1, Sb[1]); LD_ROWS(f1, QGs, 136, 3); SCAN_SB();
            MM_ROWS(oa, f0, Sb[2]); LD_ROWS(f0, ATs, 72, 0); SCAN_SB();
            MM_ROWS(oa, f1, Sb[3]);
#pragma unroll
            for (int mt = 0; mt < MT; ++mt)
#pragma unroll
                for (int r = 0; r < 4; ++r) vn[mt][r] = -vn[mt][r];
            bf16x8 Vb[KS];
#pragma unroll
            for (int s = 0; s < KS; ++s) Vb[s] = packB(vn[2 * s], vn[2 * s + 1]);
#pragma unroll
            for (int kt = 0; kt < 8; ++kt) S[kt] = S[kt] * gl;
            if (KS == 2) {
                LD_ROWS(f1, ATs, 72, KS - 1); SCAN_SB();
                MM_ROWS(oa, f0, Vb[0]); LD_KT(f0, 0, 0); SCAN_SB();
                MM_ROWS(oa, f1, Vb[KS - 1]); LD_KT(f1, 0, 4); SCAN_SB();
                MM_KT(f0, Vb[0], 0); LD_KT(f0, KS - 1, 0); SCAN_SB();
                MM_KT(f1, Vb[0], 4); LD_KT(f1, KS - 1, 4); SCAN_SB();
                MM_KT(f0, Vb[KS - 1], 0); SCAN_SB();
                MM_KT(f1, Vb[KS - 1], 4);
            } else {
                LD_KT(f1, 0, 0); SCAN_SB();
                MM_ROWS(oa, f0, Vb[0]); LD_KT(f0, 0, 4); SCAN_SB();
                MM_KT(f1, Vb[0], 0); SCAN_SB();
                MM_KT(f0, Vb[0], 4);
            }
            { bf16_t* op = mixcat + (size_t)(row0 + kq * 4) * 1024 + 512 + h * 128 + vcol;
#pragma unroll
              for (int mt = 0; mt < MT; ++mt) {
#pragma unroll
                for (int r = 0; r < 4; ++r) { *op = f2bf(oa[mt][r]); op += 1024; asm volatile("" : "+v"(op)); }
                op += 12 * 1024; asm volatile("" : "+v"(op)); } }
#undef LD_ROWS
#undef LD_KT
#undef MM_KT
#undef MM_ROWS
#undef SCAN_SB
        }
        __syncthreads();
#pragma unroll
        for (int mt = 0; mt < MT; ++mt) uc[mt] = un[mt];
        gl = gln;
    }
#undef SCAN_ISSUE
#undef SCAN_STORE
#undef U_ISSUE
    if (active) { float* od = P.out + (sample ? O_SDELTA : O_PDELTA) + ((size_t)(l * 8 + b) * 4 + h) * 16384;
#pragma unroll
        for (int kt = 0; kt < 8; ++kt)
#pragma unroll
            for (int r = 0; r < 4; ++r) od[(16 * kt + kq * 4 + r) * 128 + vcol] = S[kt][r]; }
    __syncthreads();
}
__device__ __forceinline__ void phase_gnorm(const Params& P, int l) {
    const int tid = tid_l(), lane = tid & 63, wave = tid >> 6;
    bf16_t* mixcat = (bf16_t*)(P.ws + WS_ACT); const bf16_t* p = (const bf16_t*)(P.ws + WS_A);
    const float* gn = P.in[17] + l * 128 + (lane & 15) * 8;
    const f32x4 g0 = *(const f32x4*)gn, g1 = *(const f32x4*)(gn + 4);
    const int rstride = gridDim.x * 8; int r = bid_l() * 8 + wave;
    u32x4 ov, zv;
    if (r < TT) { ov = *(const u32x4*)(mixcat + (size_t)r * 1024 + 512 + lane * 8); zv = *(const u32x4*)(p + (size_t)r * 3072 + 2560 + lane * 8); }
    for (; r < TT; r += rstride) {
        u32x4 on, zn; const int rn_ = r + rstride;
        if (rn_ < TT) { on = *(const u32x4*)(mixcat + (size_t)rn_ * 1024 + 512 + lane * 8); zn = *(const u32x4*)(p + (size_t)rn_ * 3072 + 2560 + lane * 8); }
        float o[8], z[8]; float ss = 0.f;
#pragma unroll
        for (int e = 0; e < 4; ++e) { o[2 * e] = bflo(ov[e]); o[2 * e + 1] = bfhi(ov[e]); z[2 * e] = bflo(zv[e]); z[2 * e + 1] = bfhi(zv[e]); }
#pragma unroll
        for (int e = 0; e < 8; ++e) ss += o[e] * o[e];
        ss += __shfl_xor(ss, 1); ss += __shfl_xor(ss, 2); ss += __shfl_xor(ss, 4); ss += __shfl_xor(ss, 8);
        const float rstd = rsqrtf(ss * (1.f / 128.f) + 1e-6f);
        u32x4 w; w.x = pk2(o[0] * rstd * g0[0] * z[0], o[1] * rstd * g0[1] * z[1]); w.y = pk2(o[2] * rstd * g0[2] * z[2], o[3] * rstd * g0[3] * z[3]);
        w.z = pk2(o[4] * rstd * g1[0] * z[4], o[5] * rstd * g1[1] * z[5]); w.w = pk2(o[6] * rstd * g1[2] * z[6], o[7] * rstd * g1[3] * z[7]);
        *(u32x4*)(mixcat + (size_t)r * 1024 + 512 + lane * 8) = w;
        ov = on; zv = zn;
    }
}

template <int PC> __device__ __forceinline__ void sgu_item(const Params& P, int l, int b, int row0, bool sample, int g0, int g1, LAS unsigned char* lds) {
    constexpr int LDV = PC + 8, KS = PC / 32;
#define SGU_SWZ(c_) ((((c_) >> 3) & (PC / 8 - 1)) << 3)
    const int tid = tid_l(), lane = tid & 63, wave = tid >> 6, m = lane & 15, kq = lane >> 4;
    LAS bf16_t* vT = (LAS bf16_t*)lds;
    LAS float* rstd = (LAS float*)(lds + 128 * LDV * 2);
    const bf16_t* p = (const bf16_t*)(P.ws + WS_A); bf16_t* mixcat = (bf16_t*)(P.ws + WS_ACT);
    { u32x4 rw[PC / 8];
#pragma unroll
        for (int i = 0; i < PC / 8; ++i) rw[i] = *(const u32x4*)(p + (size_t)(row0 + wave + 8 * i) * 3072 + 512 + lane * 8);
#pragma unroll
        for (int i = 0; i < PC / 8; ++i) { float ss = 0.f;
#pragma unroll
            for (int e = 0; e < 4; ++e) { const float a = bflo(rw[i][e]), c = bfhi(rw[i][e]); ss += a * a + c * c; }
            ss = wave_sum(ss); if (lane == 0) rstd[wave + 8 * i] = rsqrtf(ss * (1.f / 512.f) + 1e-6f); } }
    __syncthreads();
    for (int g = g0; g < g1; ++g) {
        const float* gam = P.in[11] + l * 512 + g * 128;
        constexpr int NBV = PC / 32;
        u32x4 rv[NBV];
#pragma unroll
        for (int i = 0; i < NBV; ++i) { const int idx = tid + 512 * i, q = idx >> 4, c8 = (idx & 15) * 8; rv[i] = *(const u32x4*)(p + (size_t)(row0 + q) * 3072 + 512 + g * 128 + c8); }
#pragma unroll
        for (int i = 0; i < NBV; ++i) { const int idx = tid + 512 * i, q = idx >> 4, c8 = (idx & 15) * 8; const u32x4 raw = rv[i]; const float rs = rstd[q];
#pragma unroll
            for (int e = 0; e < 8; ++e) { const float x = (e & 1) ? bfhi(raw[e >> 1]) : bflo(raw[e >> 1]); const float vn = x * rs * gam[c8 + e];
                vT[(c8 + e) * LDV + (q ^ SGU_SWZ(c8))] = f2bf(vn);
                if (sample) P.out[O_SGUV + ((size_t)(l * 8 + b) * 32 + q) * 512 + g * 128 + c8 + e] = vn; } }
        __syncthreads();
        int pt, ct0, nks;
        if (PC == 128) { pt = wave; ct0 = 0; nks = (pt < 4) ? 2 : 4; } else { pt = wave & 1; ct0 = (wave >> 1) * 2; nks = 1; }
        const int prow = 16 * pt + m; const float* wrow = P.in[12] + ((size_t)(l * 4 + g) * 128 + prow) * 128;
        bf16x8 Wf[KS];
#pragma unroll
        for (int s = 0; s < KS; ++s) { if (s < nks) { const f32x4 a = *(const f32x4*)(wrow + 32 * s + kq * 8), c = *(const f32x4*)(wrow + 32 * s + kq * 8 + 4);
                Wf[s] = mk8(pk2(a[0], a[1]), pk2(a[2], a[3]), pk2(c[0], c[1]), pk2(c[2], c[3])); } else Wf[s] = mk8(0u, 0u, 0u, 0u); }
        const float bias = P.in[13][(l * 4 + g) * 128 + prow];
        const size_t row = (size_t)(row0 + prow);
        constexpr int NCT = PC == 128 ? 8 : 2;
        u32x2 urv[NCT];
#pragma unroll
        for (int i = 0; i < NCT; ++i) urv[i] = *(const u32x2*)(p + row * 3072 + g * 128 + 16 * (ct0 + i) + kq * 4);
#pragma unroll
        for (int i = 0; i < NCT; ++i) { const int ct = ct0 + i; f32x4 acc = {0.f, 0.f, 0.f, 0.f};
#pragma unroll
            for (int s = 0; s < KS; ++s) if (s < nks) acc = MFMA16(*(const LAS bf16x8*)(vT + (16 * ct + m) * LDV + ((32 * s + kq * 8) ^ SGU_SWZ(16 * ct + m))), Wf[s], acc);
            const int ch = g * 128 + 16 * ct + kq * 4;
            const u32x2 ur = urv[i];
            u32x2 w; w.x = pk2(bflo(ur.x) * (acc[0] + bias), bfhi(ur.x) * (acc[1] + bias)); w.y = pk2(bflo(ur.y) * (acc[2] + bias), bfhi(ur.y) * (acc[3] + bias));
            *(u32x2*)(mixcat + row * 1024 + ch) = w; }
        __syncthreads();
    }
}
__device__ __forceinline__ void phase_scan_sgu(const Params& P, int l, LAS unsigned char* lds) {
    const int bid = bid_l(); const bool isScan = bid < 128; const int j = bid - 128;
    if (isScan) scan_job<64>(P, l, (bid & 7) + 8 * (bid >> 5), (bid >> 3) & 3, false, lds);
    else scan_job<32>(P, l, (j & 7) + 8 * (j >> 5), (j >> 3) & 3, true, lds);
    const int nq = isScan ? 1 : 3;
    for (int k = 0; k < nq; ++k) { const int qi = isScan ? 384 + bid : j + 128 * k; const int it = qi >> 2, g = qi & 3, b = it >> 4, n = it & 15;
        sgu_item<128>(P, l, b, b * 2048 + n * 128, false, g, g + 1, lds); }
    if (!isScan && j < 8) sgu_item<32>(P, l, j, TP + j * 32, true, 0, 4, lds);
}

#define XB_TMO      128
#define XB_XCNT(j)  (256  + 64 * (j))
#define XB_XSUB(j)  (1280 + 64 * (j))
#define XB_XGEN(j)  (2304 + 64 * (j))
#define XB_TOP      3328
#define XB_TOPGEN   3392
#define XCD_BAR_WORDS 3456
#define XB_SPIN_CAP (1u << 18)

__device__ __forceinline__ unsigned xb_ld(unsigned* p)              { return __hip_atomic_load(p, __ATOMIC_RELAXED, __HIP_MEMORY_SCOPE_AGENT); }
__device__ __forceinline__ unsigned xb_add(unsigned* p, unsigned v) { return __hip_atomic_fetch_add(p, v, __ATOMIC_RELAXED, __HIP_MEMORY_SCOPE_AGENT); }
__device__ __forceinline__ unsigned xb_xcc_id() { return (unsigned)__builtin_amdgcn_s_getreg((3 << 11) | 20) & 0xFu; }
#define XB_SPIN(cond, bar) do { unsigned _sp = 0; while (cond) { __builtin_amdgcn_s_sleep(1); \
    if ((++_sp & 255u) == 0u) { if (xb_ld(&(bar)[XB_TMO])) break; if (_sp > XB_SPIN_CAP) { atomicAdd(&(bar)[XB_TMO], 1u); break; } } } } while (0)

struct XcdBarrier {
    unsigned* bar; unsigned x;
    volatile LAS unsigned* st;
};

__device__ __forceinline__ XcdBarrier xcd_barrier_post(unsigned* bar, volatile LAS unsigned* st) {
    XcdBarrier b; b.bar = bar; b.x = xb_xcc_id(); b.st = st;
    if (threadIdx.x == 0) (void)xb_add(&bar[XB_XCNT(b.x)], 1u);
    return b;
}
__device__ __forceinline__ void xcd_barrier_complete(unsigned* bar, unsigned x, unsigned& nloc, unsigned& nx) {
    const unsigned G = gridDim.x * gridDim.y * gridDim.z;
    unsigned sum, cnt, mine, sp = 0u;
    for (;;) {
        sum = 0u; cnt = 0u; mine = 0u;
#pragma unroll
        for (unsigned j = 0; j < 16; ++j) { const unsigned c = xb_ld(&bar[XB_XCNT(j)]); sum += c; cnt += (c > 0u) ? 1u : 0u; mine = (j == x) ? c : mine; }
        if (sum == G) break;
        __builtin_amdgcn_s_sleep(1);
        if ((++sp & 255u) == 0u) { if (xb_ld(&bar[XB_TMO])) break; if (sp > XB_SPIN_CAP) { atomicAdd(&bar[XB_TMO], 1u); break; } }
    }
    nloc = mine > 0u ? mine : 1u; nx = cnt > 0u ? cnt : 1u;
}

__device__ __forceinline__ void xcd_barrier(const XcdBarrier& b) {
    asm volatile("s_waitcnt vmcnt(0)" ::: "memory");
    __syncthreads();
    if (threadIdx.x == 0) {
        unsigned* bar = b.bar;
        __builtin_amdgcn_s_waitcnt(0);
        unsigned nloc = b.st[0], nx = b.st[1];
        if (nloc == 0u) { xcd_barrier_complete(bar, b.x, nloc, nx); b.st[0] = nloc; b.st[1] = nx; }
        const unsigned old = xb_add(&bar[XB_XSUB(b.x)], 1u);
        const unsigned gen = old / nloc;
        if (old + 1u == (gen + 1u) * nloc) {
            __builtin_amdgcn_fence(__ATOMIC_RELEASE, "agent");
            asm volatile("s_waitcnt vmcnt(0)" ::: "memory");
            const unsigned og = xb_add(&bar[XB_TOP], 1u);
            const unsigned tg = og / nx;
            if (og + 1u == (tg + 1u) * nx) xb_add(&bar[XB_TOPGEN], 1u);
            else XB_SPIN(xb_ld(&bar[XB_TOPGEN]) == tg, bar);
            __builtin_amdgcn_fence(__ATOMIC_ACQUIRE, "agent");
            xb_add(&bar[XB_XGEN(b.x)], 1u);
            asm volatile("s_waitcnt vmcnt(0)" ::: "memory");
        } else {
            XB_SPIN(xb_ld(&bar[XB_XGEN(b.x)]) == gen, bar);
            __builtin_amdgcn_fence(__ATOMIC_ACQUIRE, "agent");
            asm volatile("s_waitcnt vmcnt(0)" ::: "memory");
        }
    }
    __syncthreads();
}

__device__ __forceinline__ void phase_final(const Params& P) {
    const int tid = tid_l(), lane = tid & 63, wave = tid >> 6, gw = bid_l() * 8 + wave;
    const bf16_t* xs = (const bf16_t*)(P.ws + WS_B);
    f32x4 g4[4];
#pragma unroll
    for (int i = 0; i < 4; ++i) g4[i] = *(const f32x4*)(P.in[21] + lane * 4 + 256 * i);
    u32x2 xr[9][4];
#pragma unroll
    for (int k = 0; k < 9; ++k) { const int r = gw + 2048 * k;
#pragma unroll
        for (int i = 0; i < 4; ++i) xr[k][i] = r < TT ? *(const u32x2*)(xs + (size_t)r * 1024 + lane * 4 + 256 * i) : (u32x2){0u, 0u}; }
#pragma unroll
    for (int k = 0; k < 9; ++k) { const int r = gw + 2048 * k;
        if (r < TT) { f32x4 v[4]; float ss = 0.f;
#pragma unroll
            for (int i = 0; i < 4; ++i) { v[i] = bf4(xr[k][i]); ss += v[i][0] * v[i][0] + v[i][1] * v[i][1] + v[i][2] * v[i][2] + v[i][3] * v[i][3]; }
            ss = wave_sum(ss); const float rstd = rsqrtf(ss * (1.f / 1024.f) + 1e-6f);
#pragma unroll
            for (int i = 0; i < 4; ++i) *(f32x4*)(P.out + (size_t)r * 1024 + lane * 4 + 256 * i) = v[i] * rstd * g4[i]; } }
}

constexpr int N_PHASES = 20;
__global__ void __launch_bounds__(512, 2) mega(Params P) {
    extern __shared__ __attribute__((aligned(16))) unsigned char lds_raw[];
    LAS unsigned char* lds = (LAS unsigned char*)lds_raw;
    cg::grid_group grid = cg::this_grid();
    unsigned* barw = (unsigned*)(P.ws + WS_BAR);
    volatile LAS unsigned* bst = (volatile LAS unsigned*)(lds + 155648);
    if (threadIdx.x < 2) bst[threadIdx.x] = 0u;
    __syncthreads();
    XcdBarrier bar = xcd_barrier_post(barw, bst);
    if (P.ph_hi > 1000) grid.sync();
    int ph = 0;
#ifndef PROBE_KIND
#define PROBE_KIND -1
#endif
#define PHASE(kind, ...) do { if (ph >= P.ph_lo && ph < P.ph_hi) { int nrep_ = ((kind) == PROBE_KIND) ? 2 : 1; asm volatile("" : "+s"(nrep_)); \
        for (int rep_ = 0; rep_ < nrep_; ++rep_) { __VA_ARGS__; if (rep_ + 1 < nrep_) __syncthreads(); } \
        if (ph + 1 < P.ph_hi) xcd_barrier(bar); } ++ph; } while (0)
    PHASE(0, phase0(P, lds));
#pragma unroll 1
    for (int l = 0; l < 2; ++l) {
        const unsigned char* wl = P.ws + (size_t)l * W_LAYER;
        const float* modl = (const float*)(P.ws + WS_MOD) + (size_t)l * 16 * 6144;
        PHASE(1, phase_h<true>(P, l, lds));
        PHASE(2, { EpiP e; e.O = (bf16_t*)(P.ws + WS_A); run_gemm<true>(lds, (const bf16_t*)(P.ws + WS_B), (const bf16_t*)(wl + W_IN), 3072, 1024, e);
                small_gemm<64, 64, 4>(lds, (const bf16_t*)(P.ws + WS_B), (const bf16_t*)(wl + W_IN), 3072, 1024, e); });
        PHASE(3, phase_b1(P, l, lds));
        PHASE(4, phase_scan_sgu(P, l, lds));
        PHASE(10, phase_gnorm(P, l));
        PHASE(5, { EpiRes e; e.base_p = P.in[0]; e.base_s = P.in[1]; e.xb = xb_ptr(P); e.xo = xb_ptr(P); e.basef32 = l == 0; e.gate = modl + 2048;
                run_gemm<false>(lds, (const bf16_t*)(P.ws + WS_ACT), (const bf16_t*)(wl + W_OUT), 1024, 1024, e);
                small_gemm<32, 32, 4>(lds, (const bf16_t*)(P.ws + WS_ACT), (const bf16_t*)(wl + W_OUT), 1024, 1024, e); });
        PHASE(6, phase_h<false>(P, l, lds));
        PHASE(7, { EpiH e; e.O = (bf16_t*)(P.ws + WS_A); run_gemm<true>(lds, (const bf16_t*)(P.ws + WS_B), (const bf16_t*)(wl + W_UP), 4096, 1024, e);
                small_gemm<64, 64, 4>(lds, (const bf16_t*)(P.ws + WS_B), (const bf16_t*)(wl + W_UP), 4096, 1024, e); });
        PHASE(8, { EpiRes e; e.base_p = P.in[0]; e.base_s = P.in[1]; e.xb = xb_ptr(P); e.xo = l == 1 ? (bf16_t*)(P.ws + WS_B) : xb_ptr(P); e.basef32 = 0; e.gate = modl + 5120;
                run_gemm<false>(lds, (const bf16_t*)(P.ws + WS_A), (const bf16_t*)(wl + W_DOWN), 1024, 4096, e);
                small_gemm<32, 32, 8>(lds, (const bf16_t*)(P.ws + WS_A), (const bf16_t*)(wl + W_DOWN), 1024, 4096, e); });
    }
    PHASE(9, phase_final(P));
#undef PHASE
}

#ifndef MK_PER_PHASE
#define MK_PER_PHASE 0
#endif
extern "C" void kernel_launch(void* const* d_in, const int* in_sizes, int n_in, void* d_out, int out_size, void* d_ws, size_t ws_size, hipStream_t stream) {
    static int grid = 0;
    if (grid == 0) {
        if (n_in != 22 || (size_t)out_size != O_END || ws_size < WS_END) { fprintf(stderr, "kernel_launch: unexpected shapes: n_in %d out %d ws %zu (need %zu)\n", n_in, out_size, ws_size, (size_t)WS_END); grid = -1; return; }
        int dev = 0, cus = 0, per_cu = 0;
        if (hipGetDevice(&dev) != hipSuccess || hipDeviceGetAttribute(&cus, hipDeviceAttributeMultiprocessorCount, dev) != hipSuccess) { grid = -1; return; }
        if (hipFuncSetAttribute((const void*)mega, hipFuncAttributeMaxDynamicSharedMemorySize, LDS_BYTES) != hipSuccess) { fprintf(stderr, "kernel_launch: hipFuncSetAttribute failed\n"); grid = -1; return; }
        if (hipOccupancyMaxActiveBlocksPerMultiprocessor(&per_cu, (const void*)mega, 512, LDS_BYTES) != hipSuccess || per_cu < 1) { fprintf(stderr, "kernel_launch: occupancy query says %d\n", per_cu); (void)hipGetLastError(); grid = -1; return; }
        if (cus < 256) { fprintf(stderr, "kernel_launch: needs 256 CUs, device has %d\n", cus); grid = -1; return; }
        grid = 256;
    }
    if (grid < 0) return;
    Params p{};
    for (int i = 0; i < 22; ++i) p.in[i] = (const float*)d_in[i];
    p.out = (float*)d_out; p.ws = (unsigned char*)d_ws;
#if MK_PER_PHASE
    for (int ph = 0; ph < N_PHASES; ++ph) { p.ph_lo = ph; p.ph_hi = ph + 1; hipLaunchKernelGGL(mega, dim3(grid), dim3(512), LDS_BYTES, stream, p); }
#else
    p.ph_lo = 0; p.ph_hi = N_PHASES;
    if (hipMemsetAsync((char*)d_ws + WS_BAR, 0, 3456 * 4, stream) != hipSuccess) { fprintf(stderr, "kernel_launch: memset of the barrier words failed\n"); return; }
    void* args[] = {&p};
    const hipError_t e = hipLaunchCooperativeKernel((const void*)mega, dim3(grid), dim3(512), args, LDS_BYTES, stream);
    if (e != hipSuccess) fprintf(stderr, "kernel_launch: cooperative launch failed: %s (grid %d)\n", hipGetErrorString(e), grid);
#endif
}
```
